# Optimizing an MI355X kernel written in HIP

```python
import math
import jax, jax.numpy as jnp
from jax import lax
import numpy as np

D_MODEL = 1024
BATCH = 4
SEQ = 4096
DEPTH = 4
DEC_BATCH = 2
DEC_SEQ = 8192
PAST_LEN = 128

GRID_W = 64
Q_BLOCK = 128
EPS = 1e-6
ROPE_THETA = 10000.0
MLA_HEADS = 8
MLA_Q_RANK = 256
MLA_KV_RANK = 128
MLA_NOPE_DIM = 64
MLA_ROPE_DIM = 32
MLA_V_DIM = 64
MLA_QK_DIM = MLA_NOPE_DIM + MLA_ROPE_DIM
MLA_WIDTH = MLA_HEADS * MLA_V_DIM
MLA_SCALE = 1.0 / math.sqrt(MLA_QK_DIM)
GQA_HEADS = 8
GQA_KV_HEADS = 2
GQA_HEAD_DIM = 64
GQA_GROUP = GQA_HEADS // GQA_KV_HEADS
GQA_WIDTH = GQA_HEADS * GQA_HEAD_DIM
GQA_KV_WIDTH = GQA_KV_HEADS * GQA_HEAD_DIM
GQA_SCALE = 1.0 / math.sqrt(GQA_HEAD_DIM)
D_MIX = MLA_WIDTH + GQA_WIDTH
IN_SPLIT_SIZES = (MLA_Q_RANK, MLA_KV_RANK, MLA_ROPE_DIM, MLA_WIDTH,
                  GQA_WIDTH, GQA_KV_WIDTH, GQA_KV_WIDTH, GQA_WIDTH)
D_IN_PROJ = sum(IN_SPLIT_SIZES)

kernel_name = "hybrid_mla_axial_gqa_encoder"


def rms_norm(x, g):
    xf = x.astype(jnp.float32)
    y = xf * lax.rsqrt(jnp.mean(xf * xf, axis=-1, keepdims=True) + EPS)
    return (y * g.astype(jnp.float32)).astype(x.dtype)


def rotate(x, pos):
    d = x.shape[-1]
    half = d // 2
    inv = ROPE_THETA ** (-jnp.arange(half, dtype=jnp.float32) / half)
    ang = pos.astype(jnp.float32)[:, None] * inv[None, :]
    cos, sin = jnp.cos(ang), jnp.sin(ang)
    xf = x.astype(jnp.float32)
    x1, x2 = xf[..., :half], xf[..., half:]
    return jnp.concatenate([x1 * cos - x2 * sin, x1 * sin + x2 * cos], axis=-1).astype(x.dtype)


def axial_rotate(x, row, col):
    h = x.shape[-1] // 2
    return jnp.concatenate([rotate(x[..., :h], row), rotate(x[..., h:], col)], axis=-1)


def block_attention(q, k, v, scale):
    B, Hk, G, S, dk = q.shape
    dv = v.shape[-1]
    nb = S // Q_BLOCK
    qb = q.reshape(B, Hk, G, nb, Q_BLOCK, dk).transpose(3, 0, 1, 2, 4, 5)

    def one(qblk):
        s = jnp.einsum('bkgqd,bksd->bkgqs', qblk, k, preferred_element_type=jnp.float32) * scale
        p = jax.nn.softmax(s, axis=-1).astype(v.dtype)
        return jnp.einsum('bkgqs,bksd->bkgqd', p, v)

    o = lax.map(one, qb)
    return o.transpose(1, 2, 3, 0, 4, 5).reshape(B, Hk * G, S, dv)


def heads_to_tokens(o):
    B, H, S, d = o.shape
    return o.transpose(0, 2, 1, 3).reshape(B, S, H * d)


def mixer_layer(x, c, t, row, col, w_ada, b_ada, g_norm, w_in, g_qa, w_uq, g_kva, w_ukv, g_qn, g_kn, w_out):
    B, S, _ = x.shape
    mod = jax.nn.silu(c) @ w_ada + b_ada
    shift, scale, gate = jnp.split(mod, 3, axis=-1)
    h = rms_norm(x, g_norm) * (1 + scale[:, None, :]) + shift[:, None, :]

    proj = h @ w_in
    parts = []
    off = 0
    for sz in IN_SPLIT_SIZES:
        parts.append(proj[..., off:off + sz])
        off += sz
    q_lat, kv_lat, k_rope, z_a, q_b, k_b, v_b, z_b = parts

    qa = (rms_norm(q_lat, g_qa) @ w_uq).reshape(B, S, MLA_HEADS, MLA_QK_DIM).transpose(0, 2, 1, 3)
    qa = jnp.concatenate([qa[..., :MLA_NOPE_DIM], rotate(qa[..., MLA_NOPE_DIM:], t)], axis=-1)
    kv = (rms_norm(kv_lat, g_kva) @ w_ukv).reshape(B, S, MLA_HEADS, MLA_NOPE_DIM + MLA_V_DIM).transpose(0, 2, 1, 3)
    k_nope, va = kv[..., :MLA_NOPE_DIM], kv[..., MLA_NOPE_DIM:]
    k_pe = rotate(k_rope, t)[:, None, :, :]
    ka = jnp.concatenate([k_nope, jnp.broadcast_to(k_pe, (B, MLA_HEADS, S, MLA_ROPE_DIM))], axis=-1)
    oa = block_attention(qa[:, :, None], ka, va, MLA_SCALE)
    ya = heads_to_tokens(oa) * jax.nn.silu(z_a)

    qb = q_b.reshape(B, S, GQA_HEADS, GQA_HEAD_DIM).transpose(0, 2, 1, 3)
    kb = k_b.reshape(B, S, GQA_KV_HEADS, GQA_HEAD_DIM).transpose(0, 2, 1, 3)
    vb = v_b.reshape(B, S, GQA_KV_HEADS, GQA_HEAD_DIM).transpose(0, 2, 1, 3)
    qb = axial_rotate(rms_norm(qb, g_qn), row, col)
    kb = axial_rotate(rms_norm(kb, g_kn), row, col)
    qb = qb.reshape(B, GQA_KV_HEADS, GQA_GROUP, S, GQA_HEAD_DIM)
    ob = block_attention(qb, kb, vb, GQA_SCALE)
    yb = heads_to_tokens(ob) * jax.nn.silu(z_b)

    out = jnp.concatenate([ya, yb], axis=-1) @ w_out
    return x + gate[:, None, :] * out


def trunk(x, c, w_ada, b_ada, g_norm, w_in, g_qa, w_uq, g_kva, w_ukv, g_qn, g_kn, w_out, g_final):
    S = x.shape[1]
    rows = S // GRID_W
    t = jnp.arange(S, dtype=jnp.int32)
    row = jnp.repeat(jnp.arange(rows, dtype=jnp.int32), GRID_W)
    col = jnp.tile(jnp.arange(GRID_W, dtype=jnp.int32), rows)
    for l in range(DEPTH):
        x = mixer_layer(x, c, t, row, col, w_ada[l], b_ada[l], g_norm[l], w_in[l], g_qa[l], w_uq[l],
                        g_kva[l], w_ukv[l], g_qn[l], g_kn[l], w_out[l])
    return rms_norm(x, g_final)


def setup_inputs(seed: int = 0) -> dict:
    key = jax.random.key(seed)
    ks = jax.random.split(key, 20)
    f32 = jnp.float32

    def w(k, shape, fan_in, mult=1.0):
        return jax.random.normal(k, shape, f32) * (mult * fan_in ** -0.5)

    def gain(k, shape):
        return 1.0 + 0.02 * jax.random.normal(k, shape, f32)

    return {
        "x_prompt": jax.random.normal(ks[0], (BATCH, SEQ, D_MODEL), f32),
        "x_sample": jax.random.normal(ks[1], (DEC_BATCH, DEC_SEQ, D_MODEL), f32),
        "c_prompt": jax.random.normal(ks[2], (BATCH, D_MODEL), f32),
        "c_sample": jax.random.normal(ks[3], (DEC_BATCH, D_MODEL), f32),
        "w_ada": w(ks[4], (DEPTH, D_MODEL, 3 * D_MODEL), D_MODEL, 0.5),
        "b_ada": 0.02 * jax.random.normal(ks[5], (DEPTH, 3 * D_MODEL), f32),
        "g_norm": gain(ks[6], (DEPTH, D_MODEL)),
        "w_in": w(ks[7], (DEPTH, D_MODEL, D_IN_PROJ), D_MODEL),
        "g_qa": gain(ks[8], (DEPTH, MLA_Q_RANK)),
        "w_uq": w(ks[9], (DEPTH, MLA_Q_RANK, MLA_HEADS * MLA_QK_DIM), MLA_Q_RANK),
        "g_kva": gain(ks[10], (DEPTH, MLA_KV_RANK)),
        "w_ukv": w(ks[11], (DEPTH, MLA_KV_RANK, MLA_HEADS * (MLA_NOPE_DIM + MLA_V_DIM)), MLA_KV_RANK),
        "g_qn": gain(ks[12], (DEPTH, GQA_HEAD_DIM)),
        "g_kn": gain(ks[13], (DEPTH, GQA_HEAD_DIM)),
        "w_out": w(ks[14], (DEPTH, D_MIX, D_MODEL), D_MIX),
        "g_final": gain(ks[15], (D_MODEL,)),
    }


def reference(x_prompt, x_sample, c_prompt, c_sample, w_ada, b_ada, g_norm, w_in, g_qa, w_uq,
              g_kva, w_ukv, g_qn, g_kn, w_out, g_final):
    y_prompt = trunk(x_prompt, c_prompt, w_ada, b_ada, g_norm, w_in, g_qa, w_uq, g_kva, w_ukv,
                     g_qn, g_kn, w_out, g_final)
    y_sample = trunk(x_sample, c_sample, w_ada, b_ada, g_norm, w_in, g_qa, w_uq, g_kva, w_ukv,
                     g_qn, g_kn, w_out, g_final)
    return (y_prompt, y_sample)
```

```cpp
#include <hip/hip_runtime.h>
#include <hip/hip_cooperative_groups.h>
#include <cstdio>
#include <cstdint>
namespace cg = cooperative_groups;
#ifndef PROBE_ATTN2
#define PROBE_ATTN2 0
#endif
#ifndef PROBE_GEMM2
#define PROBE_GEMM2 0
#endif
#ifndef PROBE_MISC2
#define PROBE_MISC2 0
#endif

typedef unsigned short bf16_t;
using bf16x8 = __attribute__((ext_vector_type(8))) short;
using s16x4  = __attribute__((ext_vector_type(4))) short;
using f32x16 = __attribute__((ext_vector_type(16))) float;
using f32x4  = __attribute__((ext_vector_type(4))) float;
using u32x4  = __attribute__((ext_vector_type(4))) unsigned;
using u32x2  = __attribute__((ext_vector_type(2))) unsigned;

constexpr int DM = 1024, NTOK = 32768, TOKP = 16384, NLAYER = 4, NPROJ = 2208, NPAD = 2304;
constexpr float EPS = 1e-6f;
constexpr float LOG2E = 1.4426950408889634f;
constexpr float C_GQA = 0.125f * LOG2E, C_MLA = 0.10206207261596575f * LOG2E;
constexpr int NTHR = 512;
constexpr size_t OFF_WTIN  = 0;
constexpr size_t OFF_WTUQ  = OFF_WTIN  + (size_t)4 * 2304 * 1024 * 2;
constexpr size_t OFF_WTUKV = OFF_WTUQ  + (size_t)4 * 768 * 256 * 2;
constexpr size_t OFF_WTOUT = OFF_WTUKV + (size_t)4 * 1024 * 128 * 2;
constexpr size_t OFF_MOD   = OFF_WTOUT + (size_t)4 * 1024 * 1024 * 2;
constexpr size_t OFF_ROPE  = OFF_MOD   + (size_t)4 * 6 * 3072 * 4;
constexpr size_t OFF_SSQQ  = OFF_ROPE  + (size_t)8192 * 16 * 8;
constexpr size_t OFF_SSQKV = OFF_SSQQ  + (size_t)NTOK * 4 * 4;
constexpr size_t OFF_G     = OFF_SSQKV + (size_t)NTOK * 4 * 4;
constexpr size_t OFF_QB    = OFF_G     + (size_t)NTOK * 1024 * 2;
constexpr size_t OFF_KB    = OFF_QB    + (size_t)NTOK * 512 * 2;
constexpr size_t OFF_VB    = OFF_KB    + (size_t)NTOK * 128 * 2;
constexpr size_t OFF_KROPE = OFF_VB    + (size_t)NTOK * 128 * 2;
constexpr size_t OFF_QLAT  = OFF_KROPE + (size_t)NTOK * 32 * 2;
constexpr size_t OFF_KVLAT = OFF_QLAT  + (size_t)NTOK * 256 * 2;
constexpr size_t OFF_H     = OFF_KVLAT + (size_t)NTOK * 128 * 2;
constexpr size_t OFF_KRSS  = OFF_H     + (size_t)NTOK * 1024 * 2;
constexpr size_t OFF_KMAX  = OFF_KRSS  + (size_t)NTOK * 4;
constexpr size_t OFF_BAR   = OFF_KMAX  + 1024;
constexpr size_t OFF_SSQX  = OFF_BAR   + 16384;
constexpr size_t OFF_SW    = OFF_SSQX  + (size_t)NTOK * 16 * 4;
constexpr size_t WS_END    = OFF_SW    + (size_t)4 * 6 * NPAD * 4;
constexpr int LDS_RING = 131072, LDS_BYTES = LDS_RING + 16;

struct Params {
  const float *x_prompt, *x_sample, *c_prompt, *c_sample, *w_ada, *b_ada, *g_norm, *w_in, *g_qa, *w_uq, *g_kva, *w_ukv, *g_qn, *g_kn, *w_out, *g_final;
  float* out; char* ws;
};

__device__ __forceinline__ unsigned cvtpk(float lo, float hi) { unsigned r; asm volatile("v_cvt_pk_bf16_f32 %0, %1, %2" : "=v"(r) : "v"(lo), "v"(hi)); return r; }
typedef __bf16 bf16x2_t __attribute__((ext_vector_type(2)));
typedef float f32x2_t __attribute__((ext_vector_type(2)));
__device__ __forceinline__ unsigned cvtpk_s(float lo, float hi) { f32x2_t v = {lo, hi}; bf16x2_t b = __builtin_convertvector(v, bf16x2_t); return __builtin_bit_cast(unsigned, b); }
__device__ __forceinline__ float bf2f(bf16_t v) { return __uint_as_float(((unsigned)v) << 16); }
__device__ __forceinline__ bf16_t f2bf(float f) { return (bf16_t)(cvtpk(f, f) & 0xffffu); }
__device__ __forceinline__ int crow(int r, int hi) { return (r & 3) + 8 * (r >> 2) + 4 * hi; }
#define SBAR() __builtin_amdgcn_sched_barrier(0)
#define LAS __attribute__((address_space(3)))
__device__ __forceinline__ int opaque_tid() { int t = threadIdx.x; asm volatile("" : "+v"(t)); return t; }
__device__ __forceinline__ int uni(int v) { return __builtin_amdgcn_readfirstlane(v); }

__device__ __forceinline__ void tok_info(int t, int& bb, int& s) {
  if (t < TOKP) { bb = t >> 12; s = t & 4095; } else { int u = t - TOKP; bb = 4 + (u >> 13); s = u & 8191; }
}
template <int NH> __device__ __forceinline__ int hm_row(int t, int h) {
  if (t < TOKP) { int b = t >> 12, s = t & 4095; return (b * NH + h) * 4096 + s; }
  int u = t - TOKP, b = u >> 13, s = u & 8191; return 4 * NH * 4096 + (b * NH + h) * 8192 + s;
}

__device__ __forceinline__ int in_srccol(int n) {
  if (n < 416) return n;
  if (n < 512) return -1;
  if (n < 1280) {
    const int q = n - 512, tq = q >> 8, p = q & 255, slot = (p >> 5) & 3, dim = (p >> 7) * 32 + (p & 31), lg = slot * 64 + dim;
    if (tq < 2) return 928 + tq * 256 + lg;
    return lg < 128 ? 1440 + lg : 1568 + (lg - 128);
  }
  if (n < 1792) return 416 + (n - 1280);
  return 1696 + (n - 1792);
}
__device__ __forceinline__ void transpose_item(const float* __restrict__ src, int ldn, int K, int k0, int n0, int mode, const float* __restrict__ gk,
                                               bf16_t* __restrict__ dst, float* lds) {
  const int tid = threadIdx.x, nn = tid & 63, kq = tid >> 6;
  const int sc = mode ? in_srccol(n0 + nn) : (n0 + nn);
#pragma unroll
  for (int i = 0; i < 8; ++i) {
    const int kk = kq + i * 8; float v = 0.f;
    if (sc >= 0) { v = src[(size_t)(k0 + kk) * ldn + sc]; if (gk) v *= gk[k0 + kk]; }
    lds[kk * 65 + nn] = v;
  }
  __syncthreads();
  const int kk2 = tid & 63;
#pragma unroll
  for (int i = 0; i < 8; ++i) { const int n2 = kq + i * 8; dst[(size_t)(n0 + n2) * K + k0 + kk2] = f2bf(lds[kk2 * 65 + n2]); }
  __syncthreads();
}

__device__ void prologue_phase(const Params& p, char* smem) {
  float* lds = (float*)smem;
  const int tid = threadIdx.x;
  bf16_t* WTIN = (bf16_t*)(p.ws + OFF_WTIN); bf16_t* WTUQ = (bf16_t*)(p.ws + OFF_WTUQ);
  bf16_t* WTUKV = (bf16_t*)(p.ws + OFF_WTUKV); bf16_t* WTOUT = (bf16_t*)(p.ws + OFF_WTOUT);
  for (int it = blockIdx.x; it < 4 * 912; it += gridDim.x) {
    const int l = it / 912, r = it % 912;
    if (r < 576) { const int kt = r / 36, nt = r % 36;
      transpose_item(p.w_in + (size_t)l * 1024 * NPROJ, NPROJ, 1024, kt * 64, nt * 64, 1, nullptr, WTIN + (size_t)l * NPAD * 1024, lds);
    } else if (r < 624) { const int q = r - 576, kt = q / 12, nt = q % 12;
      transpose_item(p.w_uq + (size_t)l * 256 * 768, 768, 256, kt * 64, nt * 64, 0, p.g_qa + l * 256, WTUQ + (size_t)l * 768 * 256, lds);
    } else if (r < 656) { const int q = r - 624, kt = q / 16, nt = q % 16;
      transpose_item(p.w_ukv + (size_t)l * 128 * 1024, 1024, 128, kt * 64, nt * 64, 0, p.g_kva + l * 128, WTUKV + (size_t)l * 1024 * 128, lds);
    } else { const int q = r - 656, kt = q / 16, nt = q % 16;
      transpose_item(p.w_out + (size_t)l * 1024 * 1024, 1024, 1024, kt * 64, nt * 64, 0, nullptr, WTOUT + (size_t)l * 1024 * 1024, lds);
    }
  }
  float* MOD = (float*)(p.ws + OFF_MOD);
  for (int it = blockIdx.x; it < 4 * 48; it += gridDim.x) {
    const int l = it / 48, n0 = (it % 48) * 64;
    float* sc = lds; float* red = lds + 6144;
    for (int i = tid; i < 6144; i += NTHR) { const int bb = i >> 10, k = i & 1023;
      const float c = bb < 4 ? p.c_prompt[bb * 1024 + k] : p.c_sample[(bb - 4) * 1024 + k];
      sc[i] = c / (1.f + __expf(-c)); }
    __syncthreads();
    const int g = tid >> 6, c = tid & 63;
    float a0 = 0, a1 = 0, a2 = 0, a3 = 0, a4 = 0, a5 = 0;
    const float* wp = p.w_ada + ((size_t)l * 1024 + g * 128) * 3072 + n0 + c;
#pragma unroll 16
    for (int k = 0; k < 128; ++k) { const float w = wp[(size_t)k * 3072]; const int kk = g * 128 + k;
      a0 += sc[kk] * w; a1 += sc[1024 + kk] * w; a2 += sc[2048 + kk] * w; a3 += sc[3072 + kk] * w; a4 += sc[4096 + kk] * w; a5 += sc[5120 + kk] * w; }
    red[(g * 6 + 0) * 64 + c] = a0; red[(g * 6 + 1) * 64 + c] = a1; red[(g * 6 + 2) * 64 + c] = a2;
    red[(g * 6 + 3) * 64 + c] = a3; red[(g * 6 + 4) * 64 + c] = a4; red[(g * 6 + 5) * 64 + c] = a5;
    __syncthreads();
    if (tid < 384) { const int bb = tid >> 6; float s = 0.f;
#pragma unroll
      for (int gg = 0; gg < 8; ++gg) s += red[(gg * 6 + bb) * 64 + c];
      MOD[(size_t)(l * 6 + bb) * 3072 + n0 + c] = s + p.b_ada[l * 3072 + n0 + c]; }
    __syncthreads();
  }
  if (blockIdx.x == 0 && tid < 192) ((unsigned*)(p.ws + OFF_KMAX))[tid] = 0u;
  float2* ROPE = (float2*)(p.ws + OFF_ROPE);
  for (int it = blockIdx.x; it < 256; it += gridDim.x) {
    const int e = it * 512 + tid, pos = e >> 4, i = e & 15, a = i >> 2, b = i & 3;
    const double pa = a == 0 ? 1.0 : a == 1 ? 0.1 : a == 2 ? 0.01 : 0.001;
    const double pb = b == 0 ? 1.0 : b == 1 ? 0.5623413251903491 : b == 2 ? 0.31622776601683794 : 0.17782794100389228;
    double rev = (double)pos * (pa * pb) * 0.15915494309189535;
    rev -= floor(rev);
    const float fr = (float)rev;
    ROPE[e] = make_float2(__builtin_amdgcn_cosf(fr), __builtin_amdgcn_sinf(fr));
  }
}

__device__ void norm_phase(const Params& p, int l, int mode) {
  const int tid = opaque_tid(), wid = uni(tid >> 6), lane = tid & 63;
  const float* MOD = (const float*)(p.ws + OFF_MOD);
  bf16_t* H = (bf16_t*)(p.ws + OFF_H);
#define XROW(r) ((mode == 0 && l == 0) ? ((r) < TOKP ? p.x_prompt + (size_t)(r) * DM : p.x_sample + (size_t)((r) - TOKP) * DM) : p.out + (size_t)(r) * DM)
  const int rstride = gridDim.x * 8;
  f32x4 v[4], nv[4];
  { const int r0 = blockIdx.x * 8 + wid; if (r0 < NTOK) { const float* xr = XROW(r0);
#pragma unroll
      for (int i = 0; i < 4; ++i) v[i] = ((const f32x4*)xr)[i * 64 + lane]; } }
  for (int row = blockIdx.x * 8 + wid; row < NTOK; row += rstride) {
    const int nrow = row + rstride;
    if (nrow < NTOK) { const float* xn = XROW(nrow);
#pragma unroll
      for (int i = 0; i < 4; ++i) nv[i] = ((const f32x4*)xn)[i * 64 + lane]; }
    float ss = 0.f;
#pragma unroll
    for (int i = 0; i < 4; ++i) ss += v[i][0] * v[i][0] + v[i][1] * v[i][1] + v[i][2] * v[i][2] + v[i][3] * v[i][3];
#pragma unroll
    for (int off = 32; off >= 1; off >>= 1) ss += __shfl_xor(ss, off);
    const float rstd = rsqrtf(ss * (1.f / 1024.f) + EPS);
    if (mode == 1) {
#pragma unroll
      for (int i = 0; i < 4; ++i) { const f32x4 g = ((const f32x4*)p.g_final)[i * 64 + lane];
        f32x4 o; o[0] = v[i][0] * rstd * g[0]; o[1] = v[i][1] * rstd * g[1]; o[2] = v[i][2] * rstd * g[2]; o[3] = v[i][3] * rstd * g[3];
        ((f32x4*)(p.out + (size_t)row * DM))[i * 64 + lane] = o; }
    } else {
      int bb, s; tok_info(row, bb, s);
      const float* md = MOD + (size_t)(l * 6 + bb) * 3072;
#pragma unroll
      for (int i = 0; i < 4; ++i) { const int ci = i * 64 + lane;
        const f32x4 g = ((const f32x4*)(p.g_norm + l * DM))[ci], sc = ((const f32x4*)(md + 1024))[ci];
        const float h0 = v[i][0] * g[0] * (1.f + sc[0]), h1 = v[i][1] * g[1] * (1.f + sc[1]);
        const float h2 = v[i][2] * g[2] * (1.f + sc[2]), h3 = v[i][3] * g[3] * (1.f + sc[3]);
        u32x2 w; w[0] = cvtpk(h0, h1); w[1] = cvtpk(h2, h3);
        *(u32x2*)(H + (size_t)row * DM + ci * 4) = w; }
      if (lane < 4) { f32x4 z = {0.f, 0.f, 0.f, 0.f}; if (lane == 0) z[0] = ss; ((f32x4*)(p.ws + OFF_SSQX))[(size_t)row * 4 + lane] = z; }
    }
#pragma unroll
    for (int i = 0; i < 4; ++i) v[i] = nv[i];
  }
#undef XROW
}


__device__ void sw_phase(const Params& p) {
  const int tid = opaque_tid(), wid = uni(tid >> 6), lane = tid & 63;
  const float* MOD = (const float*)(p.ws + OFF_MOD);
  const bf16_t* WTIN = (const bf16_t*)(p.ws + OFF_WTIN);
  float* SW = (float*)(p.ws + OFF_SW);
  for (int r = blockIdx.x * 8 + wid; r < 4 * NPAD; r += gridDim.x * 8) {
    const int l = r / NPAD, n = r % NPAD;
    const bf16_t* wr = WTIN + ((size_t)l * NPAD + n) * 1024 + lane * 16;
    const u32x4 w0 = *(const u32x4*)wr, w1 = *(const u32x4*)(wr + 8);
    float wf[16];
#pragma unroll
    for (int i = 0; i < 4; ++i) { wf[2 * i] = __uint_as_float(w0[i] << 16); wf[2 * i + 1] = __uint_as_float(w0[i] & 0xffff0000u);
      wf[8 + 2 * i] = __uint_as_float(w1[i] << 16); wf[8 + 2 * i + 1] = __uint_as_float(w1[i] & 0xffff0000u); }
#pragma unroll
    for (int bb = 0; bb < 6; ++bb) { const float* sh = MOD + (size_t)(l * 6 + bb) * 3072 + lane * 16; float a = 0.f;
#pragma unroll
      for (int i = 0; i < 4; ++i) { const f32x4 s4 = ((const f32x4*)sh)[i]; a += s4[0] * wf[4 * i] + s4[1] * wf[4 * i + 1] + s4[2] * wf[4 * i + 2] + s4[3] * wf[4 * i + 3]; }
#pragma unroll
      for (int off = 32; off >= 1; off >>= 1) a += __shfl_xor(a, off);
      if (lane == 0) SW[(size_t)(l * 6 + bb) * NPAD + n] = a; }
  }
}

#define GOFF(row, chunk) ((row) * 128 + ((((chunk)) ^ (((row) >> 1) & 7)) << 4))
enum { EPI_INPROJ = 0, EPI_KVUP = 1, EPI_OUT = 2 };

__device__ __forceinline__ void rope4(f32x4& x1, f32x4& x2, const float2* __restrict__ rp) {
  const f32x4 c01 = ((const f32x4*)rp)[0], c23 = ((const f32x4*)rp)[1];
  const float cs[4] = {c01[0], c01[2], c23[0], c23[2]}, sn[4] = {c01[1], c01[3], c23[1], c23[3]};
#pragma unroll
  for (int j = 0; j < 4; ++j) { const float a = x1[j], b = x2[j]; x1[j] = a * cs[j] - b * sn[j]; x2[j] = a * sn[j] + b * cs[j]; }
}
__device__ __forceinline__ void st_bf4(bf16_t* dst, const f32x4& v) { u32x2 w; w[0] = cvtpk(v[0], v[1]); w[1] = cvtpk(v[2], v[3]); *(u32x2*)dst = w; }
__device__ __forceinline__ float silu_f(float z) { return z * __builtin_amdgcn_rcpf(1.f + __builtin_amdgcn_exp2f(-1.4426950408889634f * z)); }

template <int EPI>
__device__ __forceinline__ void gemm_epilogue(const Params& p, int l, f32x4 (&acc)[4][4], int row0, int col0, int wr, int wc, int fr, int fq) {
  const int rbase = row0 + wr * 64 + fr;
  const int cw = col0 + wc * 64 + fq * 4;
  if constexpr (EPI == EPI_OUT) {
    const float* MOD = (const float*)(p.ws + OFF_MOD);
    int bb, s0; tok_info(row0, bb, s0);
    const float* gate = MOD + (size_t)(l * 6 + bb) * 3072 + 2048;
#pragma unroll
    for (int m = 0; m < 4; ++m) { const int t = rbase + m * 16;
      const float* xo = (l == 0) ? (t < TOKP ? p.x_prompt + (size_t)t * DM : p.x_sample + (size_t)(t - TOKP) * DM) : p.out + (size_t)t * DM;
#pragma unroll
      for (int n = 0; n < 4; ++n) { const int c = cw + n * 16; const f32x4 g = *(const f32x4*)(gate + c), x = *(const f32x4*)(xo + c);
        f32x4 o; o[0] = x[0] + g[0] * acc[m][n][0]; o[1] = x[1] + g[1] * acc[m][n][1]; o[2] = x[2] + g[2] * acc[m][n][2]; o[3] = x[3] + g[3] * acc[m][n][3];
        *(f32x4*)(p.out + (size_t)t * DM + c) = o; } }
  } else if constexpr (EPI == EPI_KVUP) {
    const float* SSQKV = (const float*)(p.ws + OFF_SSQKV);
    const float* KRSS = (const float*)(p.ws + OFF_KRSS);
    bf16_t* KVA = (bf16_t*)(p.ws + OFF_H);
    const int head = col0 >> 7;
    float kmx = 0.f;
#pragma unroll
    for (int m = 0; m < 4; ++m) { const int t = rbase + m * 16;
      const f32x4 sq = *(const f32x4*)(SSQKV + (size_t)t * 4);
      const float rstd = rsqrtf((sq[0] + sq[1] + sq[2] + sq[3]) * (1.f / 128.f) + EPS);
      bf16_t* dst = KVA + (size_t)hm_row<8>(t, head) * 128 + wc * 64 + fq * 4;
      float ss = 0.f;
#pragma unroll
      for (int n = 0; n < 4; ++n) { f32x4 v = acc[m][n] * rstd; ss += v[0] * v[0] + v[1] * v[1] + v[2] * v[2] + v[3] * v[3]; st_bf4(dst + n * 16, v); }
      ss += __shfl_xor(ss, 16); ss += __shfl_xor(ss, 32);
      kmx = fmaxf(kmx, ss + KRSS[t]); }
    if (wc == 0) {
#pragma unroll
      for (int off = 1; off < 16; off <<= 1) kmx = fmaxf(kmx, __shfl_xor(kmx, off));
      int bb, s0; tok_info(row0, bb, s0);
      if (fr == 0 && fq == 0) atomicMax((unsigned*)(p.ws + OFF_KMAX) + (l * 6 + bb) * 8 + head, __float_as_uint(kmx));
    }
  } else {
    const int ct = col0 >> 7;
    const float2* ROPE = (const float2*)(p.ws + OFF_ROPE);
    if (ct < 3) {
      bf16_t* dstb = ct < 2 ? (bf16_t*)(p.ws + OFF_QLAT) : (bf16_t*)(p.ws + OFF_KVLAT);
      const int ld = ct < 2 ? 256 : 128, cb = (ct < 2 ? col0 : 0) + wc * 64 + fq * 4;
      float* ssq = ct < 2 ? (float*)(p.ws + OFF_SSQQ) : (float*)(p.ws + OFF_SSQKV);
      const int sst = ct < 2 ? 4 : 2, sidx = (ct < 2 ? ct * 2 : 0) + wc;
#pragma unroll
      for (int m = 0; m < 4; ++m) { const int t = rbase + m * 16; float ss = 0.f;
#pragma unroll
        for (int n = 0; n < 4; ++n) { const f32x4 v = acc[m][n]; ss += v[0] * v[0] + v[1] * v[1] + v[2] * v[2] + v[3] * v[3]; st_bf4(dstb + (size_t)t * ld + cb + n * 16, v); }
        ss += __shfl_xor(ss, 16); ss += __shfl_xor(ss, 32);
        if (fq == 0) ssq[t * sst + sidx] = ss; }
    } else if (ct == 3) {
      if (wc == 0) { bf16_t* KR = (bf16_t*)(p.ws + OFF_KROPE);
#pragma unroll
        for (int m = 0; m < 4; ++m) { const int t = rbase + m * 16; int bb, s; tok_info(t, bb, s);
          f32x4 x1 = acc[m][0], x2 = acc[m][1]; rope4(x1, x2, ROPE + s * 16 + fq * 4);
          st_bf4(KR + (size_t)t * 32 + fq * 4, x1); st_bf4(KR + (size_t)t * 32 + 16 + fq * 4, x2); } }
    } else if (ct < 9) {
      const float* gv = (ct < 8 ? p.g_qn : p.g_kn) + l * 64;
      f32x4 g[4];
#pragma unroll
      for (int n = 0; n < 4; ++n) g[n] = *(const f32x4*)(gv + n * 16 + fq * 4);
#pragma unroll
      for (int m = 0; m < 4; ++m) { const int t = rbase + m * 16; int bb, s; tok_info(t, bb, s); float ss = 0.f;
#pragma unroll
        for (int n = 0; n < 4; ++n) { const f32x4 v = acc[m][n]; ss += v[0] * v[0] + v[1] * v[1] + v[2] * v[2] + v[3] * v[3]; }
        ss += __shfl_xor(ss, 16); ss += __shfl_xor(ss, 32);
        const float rstd = rsqrtf(ss * (1.f / 64.f) + EPS);
        f32x4 y[4];
#pragma unroll
        for (int n = 0; n < 4; ++n) { y[n][0] = acc[m][n][0] * rstd * g[n][0]; y[n][1] = acc[m][n][1] * rstd * g[n][1]; y[n][2] = acc[m][n][2] * rstd * g[n][2]; y[n][3] = acc[m][n][3] * rstd * g[n][3]; }
        rope4(y[0], y[1], ROPE + (s >> 6) * 16 + fq * 4);
        rope4(y[2], y[3], ROPE + (s & 63) * 16 + fq * 4);
        bf16_t* dst = ct < 8 ? (bf16_t*)(p.ws + OFF_QB) + (size_t)t * 512 + (col0 - 512) + wc * 64 + fq * 4
                             : (bf16_t*)(p.ws + OFF_KB) + (size_t)hm_row<2>(t, wc) * 64 + fq * 4;
#pragma unroll
        for (int n = 0; n < 4; ++n) st_bf4(dst + n * 16, y[n]); }
    } else if (ct == 9) {
#pragma unroll
      for (int m = 0; m < 4; ++m) { const int t = rbase + m * 16;
        bf16_t* dst = (bf16_t*)(p.ws + OFF_VB) + (size_t)hm_row<2>(t, wc) * 64 + fq * 4;
#pragma unroll
        for (int n = 0; n < 4; ++n) st_bf4(dst + n * 16, acc[m][n]); }
    } else {
      bf16_t* G = (bf16_t*)(p.ws + OFF_G);
#pragma unroll
      for (int m = 0; m < 4; ++m) { const int t = rbase + m * 16;
#pragma unroll
        for (int n = 0; n < 4; ++n) { f32x4 v; v[0] = silu_f(acc[m][n][0]); v[1] = silu_f(acc[m][n][1]); v[2] = silu_f(acc[m][n][2]); v[3] = silu_f(acc[m][n][3]);
          st_bf4(G + (size_t)t * 1024 + (cw - 1280) + n * 16, v); } }
    }
  }
}

template <int EPI>
__device__ __forceinline__ void gemm_tile(const Params& p, int l, const bf16_t* __restrict__ A, int lda, const bf16_t* __restrict__ Bt, int ldb, int K,
                                          int row0, int col0, char* lds, bool live = true) {
  const int tid = opaque_tid(), wid = uni(tid >> 6), lane = tid & 63, fr = lane & 15, fq = lane >> 4, wr = wid >> 1, wc = wid & 1;
  f32x4 acc[4][4];
#pragma unroll
  for (int m = 0; m < 4; ++m)
#pragma unroll
    for (int n = 0; n < 4; ++n) acc[m][n] = (f32x4){0.f, 0.f, 0.f, 0.f};
  const int sr = tid >> 3, sc = tid & 7;
  const bf16_t* Ag = A + (size_t)(row0 + sr) * lda + sc * 8;
  const bf16_t* Bg = Bt + (size_t)(col0 + sr) * ldb + sc * 8;
  u32x4 sa0, sa1, sa2, sa3, sb0, sb1;
#define GLOAD(kt) do { const int ko = (kt) * 64; sa0 = *(const u32x4*)(Ag + ko); sa1 = *(const u32x4*)(Ag + (size_t)64 * lda + ko); \
    sa2 = *(const u32x4*)(Ag + (size_t)128 * lda + ko); sa3 = *(const u32x4*)(Ag + (size_t)192 * lda + ko); \
    sb0 = *(const u32x4*)(Bg + ko); sb1 = *(const u32x4*)(Bg + (size_t)64 * ldb + ko); } while (0)
#define LWRITE(b) do { char* ab = lds + (b) * 49152; char* bbp = ab + 32768; \
    *(u32x4*)(ab + GOFF(sr, sc)) = sa0; *(u32x4*)(ab + GOFF(sr + 64, sc)) = sa1; *(u32x4*)(ab + GOFF(sr + 128, sc)) = sa2; *(u32x4*)(ab + GOFF(sr + 192, sc)) = sa3; \
    *(u32x4*)(bbp + GOFF(sr, sc)) = sb0; *(u32x4*)(bbp + GOFF(sr + 64, sc)) = sb1; } while (0)
  const int nk = K >> 6;
  GLOAD(0); LWRITE(0); __syncthreads();
  for (int kt = 0; kt < nk; ++kt) {
    const int cur = kt & 1;
    if (kt + 1 < nk) GLOAD(kt + 1);
    const char* ab = lds + cur * 49152; const char* bbp = ab + 32768;
#pragma unroll
    for (int kk = 0; kk < 2; ++kk) {
      bf16x8 af[4], bfr[4];
#pragma unroll
      for (int m = 0; m < 4; ++m) { const int row = wr * 64 + m * 16 + fr; af[m] = *(const bf16x8*)(ab + GOFF(row, kk * 4 + fq)); }
#pragma unroll
      for (int n = 0; n < 4; ++n) { const int row = wc * 64 + n * 16 + fr; bfr[n] = *(const bf16x8*)(bbp + GOFF(row, kk * 4 + fq)); }
#pragma unroll
      for (int m = 0; m < 4; ++m)
#pragma unroll
        for (int n = 0; n < 4; ++n) acc[m][n] = __builtin_amdgcn_mfma_f32_16x16x32_bf16(bfr[n], af[m], acc[m][n], 0, 0, 0);
    }
    if (kt + 1 < nk) LWRITE(cur ^ 1);
    __syncthreads();
  }
#undef GLOAD
#undef LWRITE
  if (live) gemm_epilogue<EPI>(p, l, acc, row0, col0, wr, wc, fr, fq);
}


namespace pg8 {
#define PG8_LAS __attribute__((address_space(3)))
typedef unsigned short bf16_t;
typedef short bf16x8 __attribute__((ext_vector_type(8)));
typedef float f32x4 __attribute__((ext_vector_type(4)));
typedef unsigned u32x4 __attribute__((ext_vector_type(4)));
constexpr int BM = 256, BK = 64, HALF = 128, HTB = HALF * BK * 2  , STAGE_BYTES = 8 * HTB, NXCD = 8, WGM = 8;

__host__ __device__ __forceinline__ int lds_byte(int r, int c) { const int st = (r >> 4) * 2 + (c >> 5), rr = r & 15, cc = c & 31, ob = rr * 64 + cc * 2; return st * 1024 + (ob ^ (((ob >> 9) & 1) << 5)); }
__host__ __device__ __forceinline__ void stage_rc(int b, int& R, int& C) { const int st = b / 1024, sb = b % 1024, swz = sb ^ (((sb >> 9) & 1) << 5); R = (st >> 1) * 16 + swz / 64; C = (st & 1) * 32 + (swz % 64) / 2; }
__host__ __device__ __forceinline__ int perm32(int rho) { const int n = rho >> 4, i = rho & 15; return 8 * (i >> 2) + 4 * n + (i & 3); }

struct Unit { int pm, pn; };
struct Gemm { const bf16_t* A; const bf16_t* Bt; int M, N, K; };

struct StaticOrder {
    int nM, nN, nwg, G, c;
    __host__ __device__ void init(int M, int N, int G_, int c_) { nM = M / BM; nN = N / BM; nwg = nM * nN; G = G_; c = c_; }
    __host__ __device__ bool next(int i, Unit& u) const {
        const long L = (long)i * G + c; if (L >= nwg) return false;
        int wgid = (int)L; { const int q = nwg / NXCD, r = nwg % NXCD, xcd = wgid % NXCD, off = wgid / NXCD; wgid = (xcd < r ? xcd * (q + 1) : r * (q + 1) + (xcd - r) * q) + off; }
        const int nig = WGM * nN, gid = wgid / nig, fm = gid * WGM, gsz = (nM - fm) < WGM ? (nM - fm) : WGM;
        u.pm = fm + ((wgid % nig) % gsz); u.pn = (wgid % nig) / gsz; return true;
    }
    __device__ __forceinline__ void a_ready(const Unit&) const {}
    __device__ __forceinline__ void done(const Unit&) const {}
};

template <class Epi, class Sched, bool ALIGN_EPI = false, bool SP2 = false>
__device__ __forceinline__ void gemm_phase(PG8_LAS unsigned char* lds, const Gemm g, const Sched& S, const Epi& E) {
    const int tid = opaque_tid(), wid = __builtin_amdgcn_readfirstlane(tid >> 6), lane = tid & 63, wr = wid >> 2, wc = wid & 3, fr = lane & 15, fq = lane >> 4;
    const int K = g.K, nt = K / BK;
    unsigned voffA[2], voffB[2];
#pragma unroll
    for (int i = 0; i < 2; ++i) { int R, C; stage_rc(tid * 16 + i * 8192, R, C); const int Rb = Epi::PERM ? ((R & ~31) + perm32(R & 31)) : R;
        voffA[i] = (unsigned)(R * K + C) * 2u; voffB[i] = (unsigned)(Rb * K + C) * 2u; }
    const size_t kstep = (size_t)(BK * 2);
    const size_t hstep = (size_t)HALF * K * 2;
    const size_t tstep = 2 * hstep;
    const unsigned ldsw = (unsigned)wid * 1024u;
    const int aoff = lds_byte(wr * 64 + fr, fq * 8), boff = lds_byte(wc * 32 + fr, fq * 8);
#define PG8_SA(b, h) (((b) * 2 + (h)) * HTB)
#define PG8_SB(b, h) ((4 + (b) * 2 + (h)) * HTB)
#define PG8_STAGE(bufoff, gbase, voff) do { _Pragma("unroll") for (int _i = 0; _i < 2; ++_i) \
        __builtin_amdgcn_global_load_lds((const unsigned*)((const char*)(gbase) + (voff)[_i]), (PG8_LAS unsigned*)(lds + (bufoff) + ldsw + _i * 8192), 16, 0, 0); } while (0)
#define PG8_LDA(dst, b, h) do { _Pragma("unroll") for (int m = 0; m < 4; ++m) _Pragma("unroll") for (int k = 0; k < 2; ++k) dst[m][k] = *(const PG8_LAS bf16x8*)(lds + PG8_SA(b, h) + aoff + m * 2048 + k * 1024); } while (0)
#define PG8_LDB(dst, b, h) do { _Pragma("unroll") for (int n = 0; n < 2; ++n) _Pragma("unroll") for (int k = 0; k < 2; ++k) dst[n][k] = *(const PG8_LAS bf16x8*)(lds + PG8_SB(b, h) + boff + n * 2048 + k * 1024); } while (0)
#define PG8_MMA(ai, bj, At, Bt) do { __builtin_amdgcn_s_setprio(1); _Pragma("unroll") for (int m = 0; m < 4; ++m) _Pragma("unroll") for (int n = 0; n < 2; ++n) _Pragma("unroll") for (int k = 0; k < 2; ++k) \
        acc[ai][bj][m][n] = __builtin_amdgcn_mfma_f32_16x16x32_bf16(Bt[n][k], At[m][k], acc[ai][bj][m][n], 0, 0, 0); __builtin_amdgcn_s_setprio(0); } while (0)
#define PG8_WAIT_V(n) asm volatile("s_waitcnt vmcnt(" #n ")" ::: "memory")
#define PG8_WAIT_L(n) asm volatile("s_waitcnt lgkmcnt(" #n ")" ::: "memory")
#define PG8_BAR __builtin_amdgcn_s_barrier()
#define PG8_SCHED __builtin_amdgcn_sched_barrier(0)
    Unit cur, nxt; int ui = 0;
    if (!S.next(0, cur)) return;
    f32x4 acc[2][2][4][2];
#pragma unroll
    for (int a = 0; a < 2; ++a)
#pragma unroll
        for (int b = 0; b < 2; ++b)
#pragma unroll
            for (int m = 0; m < 4; ++m)
#pragma unroll
                for (int n = 0; n < 2; ++n) acc[a][b][m][n] = (f32x4){0.f, 0.f, 0.f, 0.f};
    bf16x8 At[4][2], B0[2][2], B1[2][2];
    const char* cA = (const char*)g.A + (size_t)cur.pm * tstep; const char* cB = (const char*)g.Bt + (size_t)cur.pn * tstep;
    S.a_ready(cur);
    if constexpr (SP2) {
        PG8_STAGE(PG8_SB(0, 0), cB, voffB); PG8_STAGE(PG8_SB(0, 1), cB + hstep, voffB); PG8_STAGE(PG8_SA(0, 0), cA, voffA); PG8_STAGE(PG8_SA(0, 1), cA + hstep, voffA);
        if (wr == 1) PG8_BAR;
        PG8_WAIT_V(2); PG8_BAR;
        PG8_STAGE(PG8_SB(1, 0), cB + kstep, voffB); PG8_STAGE(PG8_SA(1, 0), cA + kstep, voffA); PG8_STAGE(PG8_SB(1, 1), cB + hstep + kstep, voffB);
        PG8_WAIT_V(6); PG8_BAR;
    } else {
        PG8_STAGE(PG8_SB(0, 0), cB, voffB); PG8_STAGE(PG8_SA(0, 0), cA, voffA); PG8_STAGE(PG8_SB(0, 1), cB + hstep, voffB); PG8_STAGE(PG8_SA(0, 1), cA + hstep, voffA);
        if (wr == 1) PG8_BAR;
        PG8_WAIT_V(4); PG8_BAR;
        PG8_STAGE(PG8_SB(1, 0), cB + kstep, voffB); PG8_STAGE(PG8_SA(1, 0), cA + kstep, voffA); PG8_STAGE(PG8_SB(1, 1), cB + hstep + kstep, voffB);
        PG8_WAIT_V(6); PG8_BAR;
    }
    for (;;) {
        const bool has_next = S.next(ui + 1, nxt);
        const char* nA = has_next ? (const char*)g.A + (size_t)nxt.pm * tstep : cA; const char* nB = has_next ? (const char*)g.Bt + (size_t)nxt.pn * tstep : cB;
        for (int t = 0; t < nt; t += 2) {
            const bool last = (t == nt - 2);
            const char* a1 = cA + (size_t)(t + 1) * kstep;
            const char* a2 = last ? nA : cA + (size_t)(t + 2) * kstep; const char* b2 = last ? nB : cB + (size_t)(t + 2) * kstep;
            const char* a3 = a2 + kstep; const char* b3 = b2 + kstep;
            if (last && has_next) S.a_ready(nxt);
            if constexpr (SP2) {
            PG8_LDB(B0, 0, 0); PG8_LDB(B1, 0, 1); PG8_SCHED; PG8_LDA(At, 0, 0); PG8_STAGE(PG8_SA(1, 1), a1 + hstep, voffA);
            PG8_WAIT_V(8); PG8_WAIT_L(0); PG8_BAR; PG8_MMA(0, 0, At, B0); PG8_MMA(0, 1, At, B1); PG8_BAR; PG8_SCHED;
            PG8_LDA(At, 0, 1); PG8_STAGE(PG8_SB(0, 0), b2, voffB); PG8_STAGE(PG8_SB(0, 1), b2 + hstep, voffB); PG8_STAGE(PG8_SA(0, 0), a2, voffA);
            PG8_WAIT_V(8); PG8_WAIT_L(0); PG8_BAR; PG8_MMA(1, 0, At, B0); PG8_MMA(1, 1, At, B1); PG8_BAR; PG8_SCHED;
            PG8_LDB(B0, 1, 0); PG8_LDB(B1, 1, 1); PG8_SCHED; PG8_LDA(At, 1, 0); PG8_STAGE(PG8_SA(0, 1), a2 + hstep, voffA);
            PG8_WAIT_V(8); PG8_WAIT_L(0); PG8_BAR; PG8_MMA(0, 0, At, B0); PG8_MMA(0, 1, At, B1); PG8_BAR; PG8_SCHED;
            PG8_LDA(At, 1, 1); PG8_STAGE(PG8_SB(1, 0), b3, voffB); PG8_STAGE(PG8_SB(1, 1), b3 + hstep, voffB); PG8_STAGE(PG8_SA(1, 0), a3, voffA);
            PG8_WAIT_V(8); PG8_WAIT_L(0); PG8_BAR; PG8_MMA(1, 0, At, B0); PG8_MMA(1, 1, At, B1); PG8_BAR; PG8_SCHED;
            } else {
            PG8_LDB(B0, 0, 0); PG8_SCHED; PG8_LDA(At, 0, 0); PG8_STAGE(PG8_SA(1, 1), a1 + hstep, voffA);
            PG8_WAIT_L(8); PG8_BAR; PG8_WAIT_L(0); PG8_MMA(0, 0, At, B0); PG8_BAR; PG8_SCHED;
            PG8_LDB(B1, 0, 1); PG8_STAGE(PG8_SB(0, 0), b2, voffB);
            PG8_BAR; PG8_WAIT_L(0); PG8_MMA(0, 1, At, B1); PG8_BAR;
            PG8_LDA(At, 0, 1); PG8_STAGE(PG8_SA(0, 0), a2, voffA);
            PG8_BAR; PG8_WAIT_L(0); PG8_MMA(1, 0, At, B0); PG8_BAR; PG8_SCHED;
            PG8_STAGE(PG8_SB(0, 1), b2 + hstep, voffB);
            PG8_WAIT_V(6); PG8_BAR; PG8_MMA(1, 1, At, B1); PG8_BAR;
            PG8_LDB(B0, 1, 0); PG8_SCHED; PG8_LDA(At, 1, 0); PG8_STAGE(PG8_SA(0, 1), a2 + hstep, voffA);
            PG8_WAIT_L(8); PG8_BAR; PG8_WAIT_L(0); PG8_MMA(0, 0, At, B0); PG8_BAR; PG8_SCHED;
            PG8_LDB(B1, 1, 1); PG8_STAGE(PG8_SB(1, 0), b3, voffB);
            PG8_BAR; PG8_WAIT_L(0); PG8_MMA(0, 1, At, B1); PG8_BAR;
            PG8_LDA(At, 1, 1); PG8_STAGE(PG8_SA(1, 0), a3, voffA);
            PG8_BAR; PG8_WAIT_L(0); PG8_MMA(1, 0, At, B0); PG8_BAR; PG8_SCHED;
            PG8_STAGE(PG8_SB(1, 1), b3 + hstep, voffB);
            PG8_WAIT_V(6); PG8_BAR; PG8_MMA(1, 1, At, B1); PG8_BAR;
            }
        }
        if constexpr (ALIGN_EPI) { if (wr == 0) PG8_BAR; }
        if constexpr (!Epi::AFTER_DRAIN) { E(acc, cur, wr, wc, fr, fq); S.done(cur); }
        if (!has_next) break;
#pragma unroll
        for (int a = 0; a < 2; ++a)
#pragma unroll
            for (int b = 0; b < 2; ++b)
#pragma unroll
                for (int m = 0; m < 4; ++m)
#pragma unroll
                    for (int n = 0; n < 2; ++n) acc[a][b][m][n] = (f32x4){0.f, 0.f, 0.f, 0.f};
        cur = nxt; cA = nA; cB = nB; ++ui;
        if constexpr (ALIGN_EPI) { if (wr == 1) PG8_BAR; }
    }
    PG8_WAIT_V(0);
    if constexpr (!ALIGN_EPI) { if (wr == 0) PG8_BAR; }
    PG8_BAR;
    if constexpr (Epi::AFTER_DRAIN) { E.fused(acc, cur, wr, wc, fr, fq, lds, wid, lane); S.done(cur); }
#undef PG8_SA
#undef PG8_SB
#undef PG8_STAGE
#undef PG8_LDA
#undef PG8_LDB
#undef PG8_MMA
#undef PG8_WAIT_V
#undef PG8_WAIT_L
#undef PG8_BAR
#undef PG8_SCHED
}
}

struct EpiInProj {
  static constexpr bool PERM = false, AFTER_DRAIN = false;
  char* ws; const float* gq; const float* gk; const float* swl;
  __device__ __forceinline__ float row_rstd(int t) const {
    const f32x4* q = (const f32x4*)(ws + OFF_SSQX) + (size_t)t * 4; const f32x4 a = q[0], b = q[1], c = q[2], d = q[3];
    const float s = ((a[0] + a[1]) + (a[2] + a[3])) + ((b[0] + b[1]) + (b[2] + b[3])) + ((c[0] + c[1]) + (c[2] + c[3])) + ((d[0] + d[1]) + (d[2] + d[3]));
    return rsqrtf(s * (1.f / 1024.f) + EPS); }
  __device__ __forceinline__ void operator()(const f32x4 (&acc0)[2][2][4][2], const pg8::Unit& u, int wr, int wc, int fr, int fq) const {
    const int pn = u.pn, rb = u.pm * 256 + wr * 64 + fr;
    const float2* ROPE = (const float2*)(ws + OFF_ROPE);
    int bb0, s00; tok_info(u.pm * 256, bb0, s00);
    const float* sw = swl + (size_t)bb0 * NPAD + pn * 256 + wc * 32 + fq * 4;
    f32x4 swv[2][2];
#pragma unroll
    for (int bj = 0; bj < 2; ++bj)
#pragma unroll
      for (int n = 0; n < 2; ++n) swv[bj][n] = *(const f32x4*)(sw + bj * 128 + n * 16);
#define AV(bj, n) (acc0[ai][bj][m][n] * rs + swv[bj][n])
    if (pn == 0) {
      bf16_t* Q = (bf16_t*)(ws + OFF_QLAT); float* ssq = (float*)(ws + OFF_SSQQ);
#pragma unroll
      for (int ai = 0; ai < 2; ++ai)
#pragma unroll
        for (int m = 0; m < 4; ++m) { const int t = rb + ai * 128 + m * 16; const float rs = row_rstd(t); float ss = 0.f;
#pragma unroll
          for (int bj = 0; bj < 2; ++bj)
#pragma unroll
            for (int n = 0; n < 2; ++n) { const f32x4 v = AV(bj, n); ss += v[0] * v[0] + v[1] * v[1] + v[2] * v[2] + v[3] * v[3];
              st_bf4(Q + (size_t)t * 256 + bj * 128 + wc * 32 + n * 16 + fq * 4, v); }
          ss += __shfl_xor(ss, 16); ss += __shfl_xor(ss, 32);
          if (fq == 0) ssq[t * 4 + wc] = ss; }
    } else if (pn == 1) {
      bf16_t* KV = (bf16_t*)(ws + OFF_KVLAT); float* ssq = (float*)(ws + OFF_SSQKV); bf16_t* KR = (bf16_t*)(ws + OFF_KROPE);
#pragma unroll
      for (int ai = 0; ai < 2; ++ai)
#pragma unroll
        for (int m = 0; m < 4; ++m) { const int t = rb + ai * 128 + m * 16; const float rs = row_rstd(t); float ss = 0.f;
#pragma unroll
          for (int n = 0; n < 2; ++n) { const f32x4 v = AV(0, n); ss += v[0] * v[0] + v[1] * v[1] + v[2] * v[2] + v[3] * v[3];
            st_bf4(KV + (size_t)t * 128 + wc * 32 + n * 16 + fq * 4, v); }
          ss += __shfl_xor(ss, 16); ss += __shfl_xor(ss, 32);
          if (fq == 0) ssq[t * 4 + wc] = ss;
          if (wc == 0) { int bb, s; tok_info(t, bb, s);
            f32x4 x1 = AV(1, 0), x2 = AV(1, 1);
            float rs = x1[0] * x1[0] + x1[1] * x1[1] + x1[2] * x1[2] + x1[3] * x1[3] + x2[0] * x2[0] + x2[1] * x2[1] + x2[2] * x2[2] + x2[3] * x2[3];
            rs += __shfl_xor(rs, 16); rs += __shfl_xor(rs, 32);
            if (fq == 0) ((float*)(ws + OFF_KRSS))[t] = rs;
            rope4(x1, x2, ROPE + s * 16 + fq * 4);
            st_bf4(KR + (size_t)t * 32 + fq * 4, x1); st_bf4(KR + (size_t)t * 32 + 16 + fq * 4, x2); } }
    } else if (pn <= 4) {
      if (pn == 4 && wc >= 2) {
#pragma unroll
        for (int ai = 0; ai < 2; ++ai)
#pragma unroll
          for (int m = 0; m < 4; ++m) { const int t = rb + ai * 128 + m * 16; const float rs = row_rstd(t);
            bf16_t* dst = (bf16_t*)(ws + OFF_VB) + (size_t)hm_row<2>(t, wc - 2) * 64 + fq * 4;
#pragma unroll
            for (int bj = 0; bj < 2; ++bj)
#pragma unroll
              for (int n = 0; n < 2; ++n) st_bf4(dst + bj * 32 + n * 16, AV(bj, n)); }
      } else {
        const float* gv = pn < 4 ? gq : gk;
        f32x4 g[2][2];
#pragma unroll
        for (int bj = 0; bj < 2; ++bj)
#pragma unroll
          for (int n = 0; n < 2; ++n) g[bj][n] = *(const f32x4*)(gv + bj * 32 + n * 16 + fq * 4);
#pragma unroll
        for (int ai = 0; ai < 2; ++ai)
#pragma unroll
          for (int m = 0; m < 4; ++m) { const int t = rb + ai * 128 + m * 16; const float rs = row_rstd(t); int bb, s; tok_info(t, bb, s); float ss = 0.f;
#pragma unroll
            for (int bj = 0; bj < 2; ++bj)
#pragma unroll
              for (int n = 0; n < 2; ++n) { const f32x4 v = AV(bj, n); ss += v[0] * v[0] + v[1] * v[1] + v[2] * v[2] + v[3] * v[3]; }
            ss += __shfl_xor(ss, 16); ss += __shfl_xor(ss, 32);
            const float rstd = rsqrtf(ss * (1.f / 64.f) + EPS) * (pn < 4 ? C_GQA : 1.f);
            f32x4 y[2][2];
#pragma unroll
            for (int bj = 0; bj < 2; ++bj)
#pragma unroll
              for (int n = 0; n < 2; ++n) { const f32x4 v = AV(bj, n), gg = g[bj][n];
                y[bj][n][0] = v[0] * rstd * gg[0]; y[bj][n][1] = v[1] * rstd * gg[1]; y[bj][n][2] = v[2] * rstd * gg[2]; y[bj][n][3] = v[3] * rstd * gg[3]; }
            rope4(y[0][0], y[0][1], ROPE + (s >> 6) * 16 + fq * 4);
            rope4(y[1][0], y[1][1], ROPE + (s & 63) * 16 + fq * 4);
            bf16_t* dst = pn < 4 ? (bf16_t*)(ws + OFF_QB) + (size_t)t * 512 + ((pn - 2) * 4 + wc) * 64 + fq * 4
                                 : (bf16_t*)(ws + OFF_KB) + (size_t)hm_row<2>(t, wc) * 64 + fq * 4;
#pragma unroll
            for (int bj = 0; bj < 2; ++bj)
#pragma unroll
              for (int n = 0; n < 2; ++n) st_bf4(dst + bj * 32 + n * 16, y[bj][n]); }
      }
    } else {
      bf16_t* G = (bf16_t*)(ws + OFF_G);
#pragma unroll
      for (int ai = 0; ai < 2; ++ai)
#pragma unroll
        for (int m = 0; m < 4; ++m) { const int t = rb + ai * 128 + m * 16; const float rs = row_rstd(t);
#pragma unroll
          for (int bj = 0; bj < 2; ++bj)
#pragma unroll
            for (int n = 0; n < 2; ++n) { const f32x4 a = AV(bj, n); f32x4 v; v[0] = silu_f(a[0]); v[1] = silu_f(a[1]); v[2] = silu_f(a[2]); v[3] = silu_f(a[3]);
              st_bf4(G + (size_t)t * 1024 + (pn - 5) * 256 + bj * 128 + wc * 32 + n * 16 + fq * 4, v); } }
    }
  }
#undef AV
};
struct EpiOutProj {
  static constexpr bool PERM = false, AFTER_DRAIN = false;
  const float* xp; const float* xs; float* out; const float* modl; int first;
  const float* gnext; bf16_t* H; float* ssqx; int has_next;
  __device__ __forceinline__ void operator()(const f32x4 (&acc)[2][2][4][2], const pg8::Unit& u, int wr, int wc, int fr, int fq) const {
    const int rb = u.pm * 256 + wr * 64 + fr, cb = u.pn * 256 + wc * 32 + fq * 4;
    int bb, s0; tok_info(u.pm * 256, bb, s0);
    const float* gate = modl + (size_t)bb * 3072 + 2048;
    const float* scn = modl + (size_t)(6 + bb) * 3072 + 1024;
    f32x4 gv[2][2], gm[2][2];
#pragma unroll
    for (int bj = 0; bj < 2; ++bj)
#pragma unroll
      for (int n = 0; n < 2; ++n) { const int c = cb + bj * 128 + n * 16; gv[bj][n] = *(const f32x4*)(gate + c);
        if (has_next) { const f32x4 g = *(const f32x4*)(gnext + c), s = *(const f32x4*)(scn + c);
          gm[bj][n][0] = g[0] * (1.f + s[0]); gm[bj][n][1] = g[1] * (1.f + s[1]); gm[bj][n][2] = g[2] * (1.f + s[2]); gm[bj][n][3] = g[3] * (1.f + s[3]); } }
#define XPTR(t_) (first ? ((t_) < TOKP ? xp + (size_t)(t_) * DM : xs + (size_t)((t_) - TOKP) * DM) : out + (size_t)(t_) * DM)
    f32x4 xc[2][2], xn[2][2];
    { const float* x0 = XPTR(rb);
#pragma unroll
      for (int bj = 0; bj < 2; ++bj)
#pragma unroll
        for (int n = 0; n < 2; ++n) xc[bj][n] = *(const f32x4*)(x0 + cb + bj * 128 + n * 16); }
#pragma unroll
    for (int ai = 0; ai < 2; ++ai)
#pragma unroll
      for (int m = 0; m < 4; ++m) { const int t = rb + ai * 128 + m * 16; float ss = 0.f;
        if (ai * 4 + m < 7) { const int tn = rb + ((ai * 4 + m + 1) >> 2) * 128 + ((ai * 4 + m + 1) & 3) * 16; const float* x1 = XPTR(tn);
#pragma unroll
          for (int bj = 0; bj < 2; ++bj)
#pragma unroll
            for (int n = 0; n < 2; ++n) xn[bj][n] = *(const f32x4*)(x1 + cb + bj * 128 + n * 16); }
#pragma unroll
        for (int bj = 0; bj < 2; ++bj)
#pragma unroll
          for (int n = 0; n < 2; ++n) { const int c = cb + bj * 128 + n * 16; const f32x4 g = gv[bj][n], x = xc[bj][n], a = acc[ai][bj][m][n];
            f32x4 o; o[0] = x[0] + g[0] * a[0]; o[1] = x[1] + g[1] * a[1]; o[2] = x[2] + g[2] * a[2]; o[3] = x[3] + g[3] * a[3];
            *(f32x4*)(out + (size_t)t * DM + c) = o;
            if (has_next) { ss += o[0] * o[0] + o[1] * o[1] + o[2] * o[2] + o[3] * o[3];
              f32x4 h; h[0] = o[0] * gm[bj][n][0]; h[1] = o[1] * gm[bj][n][1]; h[2] = o[2] * gm[bj][n][2]; h[3] = o[3] * gm[bj][n][3];
              st_bf4(H + (size_t)t * DM + c, h); } }
        if (has_next) { ss += __shfl_xor(ss, 16); ss += __shfl_xor(ss, 32); if (fq == 0) ssqx[t * 16 + u.pn * 4 + wc] = ss; }
#pragma unroll
        for (int bj = 0; bj < 2; ++bj)
#pragma unroll
          for (int n = 0; n < 2; ++n) xc[bj][n] = xn[bj][n]; }
#undef XPTR
  }
};

struct EpiKvUp {
  static constexpr bool PERM = false, AFTER_DRAIN = false;
  char* ws; int l;
  __device__ __forceinline__ void operator()(const f32x4 (&acc)[2][2][4][2], const pg8::Unit& u, int wr, int wc, int fr, int fq) const {
    const int rb = u.pm * 256 + wr * 64 + fr;
    const float* SSQKV = (const float*)(ws + OFF_SSQKV); const float* KRSS = (const float*)(ws + OFF_KRSS);
    bf16_t* KVA = (bf16_t*)(ws + OFF_H);
    float kmx[2] = {0.f, 0.f};
#pragma unroll
    for (int ai = 0; ai < 2; ++ai)
#pragma unroll
      for (int m = 0; m < 4; ++m) { const int t = rb + ai * 128 + m * 16;
        const f32x4 sq = *(const f32x4*)(SSQKV + (size_t)t * 4);
        const float rstd = rsqrtf((sq[0] + sq[1] + sq[2] + sq[3]) * (1.f / 128.f) + EPS);
        const float kr = wc == 0 ? KRSS[t] : 0.f;
#pragma unroll
        for (int bj = 0; bj < 2; ++bj) { bf16_t* dst = KVA + (size_t)hm_row<8>(t, u.pn * 2 + bj) * 128 + wc * 32 + fq * 4; float ss = 0.f;
#pragma unroll
          for (int n = 0; n < 2; ++n) { const f32x4 v = acc[ai][bj][m][n] * rstd; ss += v[0] * v[0] + v[1] * v[1] + v[2] * v[2] + v[3] * v[3]; st_bf4(dst + n * 16, v); }
          ss += __shfl_xor(ss, 16); ss += __shfl_xor(ss, 32);
          kmx[bj] = fmaxf(kmx[bj], ss + kr); } }
    if (wc < 2) {
      int bb, s0; tok_info(u.pm * 256, bb, s0);
      unsigned* KM = wc == 0 ? (unsigned*)(ws + OFF_KMAX) : (unsigned*)(ws + OFF_BAR) + 3584;
#pragma unroll
      for (int bj = 0; bj < 2; ++bj) { float v = kmx[bj];
#pragma unroll
        for (int off = 1; off < 16; off <<= 1) v = fmaxf(v, __shfl_xor(v, off));
        if (fr == 0 && fq == 0) atomicMax(KM + (l * 6 + bb) * 8 + u.pn * 2 + bj, __float_as_uint(v)); }
    }
  }
};

#define KOFF(row, chunk) ((row) * 256 + ((((chunk)) ^ ((row) & 15)) << 4))
constexpr int A_SHM_V = 8192, A_SHM_K = 16384;
__device__ __forceinline__ int v_st(int k, int c) { const int kk = (k & ~0xC) | ((k & 4) << 1) | ((k & 8) >> 1); return ((kk >> 3) * 2 + (c >> 5)) * 512 + ((kk & 7) * 32 + (c & 31)) * 2; }
__device__ __forceinline__ int v_rd_base(int lane) { return ((lane & 3) << 3) | (((lane >> 2) & 3) << 6) | (((lane >> 4) & 1) << 5) | (((lane >> 5) & 1) << 8); }
constexpr int v_rd_off(int d0, int ks, int half) { return d0 * 512 + ks * 2048 + half * 1024; }
template <int OFF> __device__ __forceinline__ s16x4 tr_read(int vb) {
  s16x4 r; asm volatile("ds_read_b64_tr_b16 %0, %1 offset:%2" : "=&v"(r) : "v"(vb), "i"(OFF) : "memory"); return r;
}
template <int D0> __device__ __forceinline__ void pv_one(f32x16& od, int vb, bf16x8 pa0, bf16x8 pa1, bf16x8 pa2, bf16x8 pa3) {
  const s16x4 l0 = tr_read<v_rd_off(D0, 0, 0)>(vb), h0 = tr_read<v_rd_off(D0, 0, 1)>(vb), l1 = tr_read<v_rd_off(D0, 1, 0)>(vb), h1 = tr_read<v_rd_off(D0, 1, 1)>(vb);
  const s16x4 l2 = tr_read<v_rd_off(D0, 2, 0)>(vb), h2 = tr_read<v_rd_off(D0, 2, 1)>(vb), l3 = tr_read<v_rd_off(D0, 3, 0)>(vb), h3 = tr_read<v_rd_off(D0, 3, 1)>(vb);
  asm volatile("s_waitcnt lgkmcnt(0)" ::: "memory"); SBAR();
#define PK(L, H) (bf16x8){L[0], L[1], L[2], L[3], H[0], H[1], H[2], H[3]}
  od = __builtin_amdgcn_mfma_f32_32x32x16_bf16(pa0, PK(l0, h0), od, 0, 0, 0);
  od = __builtin_amdgcn_mfma_f32_32x32x16_bf16(pa1, PK(l1, h1), od, 0, 0, 0);
  od = __builtin_amdgcn_mfma_f32_32x32x16_bf16(pa2, PK(l2, h2), od, 0, 0, 0);
  od = __builtin_amdgcn_mfma_f32_32x32x16_bf16(pa3, PK(l3, h3), od, 0, 0, 0);
#undef PK
}
#define PK4(P, BASE, OUT) do { unsigned a0_ = cvtpk(P[BASE + 0], P[BASE + 1]), a1_ = cvtpk(P[BASE + 2], P[BASE + 3]);   \
    unsigned b0_ = cvtpk(P[BASE + 4], P[BASE + 5]), b1_ = cvtpk(P[BASE + 6], P[BASE + 7]);                              \
    auto r0_ = __builtin_amdgcn_permlane32_swap(a0_, b0_, false, false); auto r1_ = __builtin_amdgcn_permlane32_swap(a1_, b1_, false, false); \
    u32x4 w_ = {r0_[0], r1_[0], r0_[1], r1_[1]}; OUT = *reinterpret_cast<bf16x8*>(&w_); } while (0)

constexpr float ATT_THRL = 11.5f;
template <int DQK>
__device__ __forceinline__ void partialSM(f32x16& p0, f32x16& p1, float& m_reg, float& mn, float& alpha) {
  float pmax = p0[0];
#pragma unroll
  for (int r = 1; r < 16; ++r) pmax = fmaxf(pmax, p0[r]);
#pragma unroll
  for (int r = 0; r < 16; ++r) pmax = fmaxf(pmax, p1[r]);
  { auto rr = __builtin_amdgcn_permlane32_swap(__float_as_uint(pmax), __float_as_uint(pmax), false, false);
    pmax = fmaxf(__uint_as_float(rr[0]), __uint_as_float(rr[1])); }
  if (__builtin_expect(__all(pmax - m_reg <= ATT_THRL), 1)) { mn = m_reg; alpha = 1.f; }
  else { mn = fmaxf(m_reg, pmax); alpha = __builtin_amdgcn_exp2f(m_reg - mn); m_reg = mn; }
#pragma unroll
  for (int r = 0; r < 16; ++r) p0[r] = p0[r] - mn;
#pragma unroll
  for (int r = 0; r < 16; ++r) p1[r] = p1[r] - mn;
#pragma unroll
  for (int r = 0; r < 16; ++r) p0[r] = __builtin_amdgcn_exp2f(p0[r]);
}
__device__ __forceinline__ void finishSM(f32x16& p0, f32x16& p1, float alpha, float& l_reg, bf16x8& pa0, bf16x8& pa1, bf16x8& pa2, bf16x8& pa3) {
#pragma unroll
  for (int r = 0; r < 16; ++r) p1[r] = __builtin_amdgcn_exp2f(p1[r]);
  float ps = 0;
#pragma unroll
  for (int r = 0; r < 16; ++r) ps += p0[r];
#pragma unroll
  for (int r = 0; r < 16; ++r) ps += p1[r];
  { auto rr = __builtin_amdgcn_permlane32_swap(__float_as_uint(ps), __float_as_uint(ps), false, false);
    ps = __uint_as_float(rr[0]) + __uint_as_float(rr[1]); }
  l_reg = l_reg * alpha + ps;
  PK4(p0, 0, pa0); PK4(p0, 8, pa1); PK4(p1, 0, pa2); PK4(p1, 8, pa3);
}
template <int DQK>
__device__ __forceinline__ void qkt(f32x16& p0, f32x16& p1, const char* Ks, const bf16x8 (&qr)[DQK / 16], int r32, int hi) {
  p0 = f32x16{}; p1 = f32x16{};
#pragma unroll
  for (int d0 = 0; d0 < DQK / 16; ++d0) { const int ch = d0 * 2 + hi;
    const bf16x8 b0 = *reinterpret_cast<const bf16x8*>(Ks + KOFF(r32, ch));
    const bf16x8 b1 = *reinterpret_cast<const bf16x8*>(Ks + KOFF(32 + r32, ch));
    p0 = __builtin_amdgcn_mfma_f32_32x32x16_bf16(b0, qr[d0], p0, 0, 0, 0);
    p1 = __builtin_amdgcn_mfma_f32_32x32x16_bf16(b1, qr[d0], p1, 0, 0, 0); }
}

template <int DQK>
__device__ __forceinline__ void attn_body(const bf16x8 (&qr)[DQK / 16], const bf16_t* __restrict__ Kg, int kld, const bf16_t* __restrict__ Krg,
                                          const bf16_t* __restrict__ Vg, int vld, int seq, bf16_t* __restrict__ Gout, char* lds, bool live) {
  const int tid = opaque_tid(), wid = uni(tid >> 6), lane = tid & 63, r32 = lane & 31, hi = lane >> 5;
  char* V_lds = lds; char* K_lds = lds + 2 * A_SHM_V;
  float* ws = (float*)(lds + 2 * A_SHM_V + 2 * A_SHM_K) + wid * 64; float* li_l = ws; float* al_l = ws + 32;
  float m_reg = -1e30f, l_reg = 0; f32x16 o[2] = {};
  const int srow = tid >> 3, sch = tid & 7, rrow = (tid & 255) >> 2, rch = tid & 3;
  const int vst = v_st(srow, sch * 8), kst = KOFF(srow, sch), rst = KOFF(rrow, 8 + rch);
  const int vb0 = (int)(uintptr_t)V_lds + v_rd_base(lane);
  const bf16_t* Kp = Kg + (size_t)srow * kld + sch * 8;
  const bf16_t* Vp = Vg + (size_t)srow * vld + sch * 8;
  const bf16_t* Rp = (DQK == 96) ? Krg + (size_t)rrow * 32 + rch * 8 : nullptr;
  u32x4 k_s0, v_s0, r_s0;
#define SLOAD0(k0) do { k_s0 = *(const u32x4*)(Kp + (size_t)(k0) * kld); v_s0 = *(const u32x4*)(Vp + (size_t)(k0) * vld); if (DQK == 96) r_s0 = *(const u32x4*)(Rp + (size_t)(k0) * 32); } while (0)
#define SWRITE0(b) do { *(u32x4*)(V_lds + (b) * A_SHM_V + vst) = v_s0; *(u32x4*)(K_lds + (b) * A_SHM_K + kst) = k_s0; if (DQK == 96) *(u32x4*)(K_lds + (b) * A_SHM_K + rst) = r_s0; } while (0)
#define RESC(a) do { if (__any((a) < 1.f)) { if (hi == 0) al_l[r32] = (a); asm volatile("s_waitcnt lgkmcnt(0)" ::: "memory"); \
    _Pragma("unroll") for (int d = 0; d < 2; ++d) _Pragma("unroll") for (int r = 0; r < 16; ++r) o[d][r] *= al_l[crow(r, hi)]; } } while (0)
#define PVALL(vb) do { pv_one<0>(o[0], (vb), pa0, pa1, pa2, pa3); pv_one<1>(o[1], (vb), pa0, pa1, pa2, pa3); } while (0)
  f32x16 pA0, pA1, pB0, pB1; float mnA, mnB, alA, alB; bf16x8 pa0, pa1, pa2, pa3; const int NT = seq / 64;
  SLOAD0(0); SWRITE0(0); __syncthreads();
  qkt<DQK>(pA0, pA1, K_lds, qr, r32, hi); partialSM<DQK>(pA0, pA1, m_reg, mnA, alA);
  SLOAD0(64); SWRITE0(1); __syncthreads();
  for (int j = 1; j + 1 < NT; j += 2) {
    SBAR(); qkt<DQK>(pB0, pB1, K_lds + A_SHM_K, qr, r32, hi);
    finishSM(pA0, pA1, alA, l_reg, pa0, pa1, pa2, pa3); SBAR();
    SLOAD0((j + 1) * 64); SBAR();
    PVALL(vb0); partialSM<DQK>(pB0, pB1, m_reg, mnB, alB);
    __syncthreads(); SWRITE0(0);
    RESC(alB); __syncthreads();
    SBAR(); qkt<DQK>(pA0, pA1, K_lds, qr, r32, hi);
    finishSM(pB0, pB1, alB, l_reg, pa0, pa1, pa2, pa3); SBAR();
    SLOAD0((j + 2) * 64); SBAR();
    PVALL(vb0 + A_SHM_V); partialSM<DQK>(pA0, pA1, m_reg, mnA, alA);
    __syncthreads(); SWRITE0(1);
    RESC(alA); __syncthreads();
  }
  SBAR(); qkt<DQK>(pB0, pB1, K_lds + A_SHM_K, qr, r32, hi);
  finishSM(pA0, pA1, alA, l_reg, pa0, pa1, pa2, pa3); SBAR();
  PVALL(vb0); partialSM<DQK>(pB0, pB1, m_reg, mnB, alB);
  __syncthreads(); RESC(alB);
  finishSM(pB0, pB1, alB, l_reg, pa0, pa1, pa2, pa3); SBAR();
  PVALL(vb0 + A_SHM_V);
  if (hi == 0) li_l[r32] = l_reg; asm volatile("s_waitcnt lgkmcnt(0)" ::: "memory");
  float rli[16];
#pragma unroll
  for (int r = 0; r < 16; ++r) rli[r] = __builtin_amdgcn_rcpf(li_l[crow(r, hi)]);
  bf16_t* Gw = Gout + (size_t)(wid * 32) * 1024 + r32;
  if (live) {
#pragma unroll
  for (int r = 0; r < 16; ++r) { const int orow = crow(r, hi);
#pragma unroll
    for (int d0 = 0; d0 < 2; ++d0) { bf16_t* gp = Gw + (size_t)orow * 1024 + d0 * 32; const float g = bf2f(*gp); *gp = f2bf(o[d0][r] * rli[r] * g); } }
  }
  __syncthreads();
#undef SLOAD0
#undef SWRITE0
#undef RESC
#undef PVALL
}


#define PK4S(P, BASE, OUT) do { unsigned a0_ = cvtpk_s(P[BASE + 0], P[BASE + 1]), a1_ = cvtpk_s(P[BASE + 2], P[BASE + 3]);   \
    unsigned b0_ = cvtpk_s(P[BASE + 4], P[BASE + 5]), b1_ = cvtpk_s(P[BASE + 6], P[BASE + 7]);                              \
    auto r0_ = __builtin_amdgcn_permlane32_swap(a0_, b0_, false, false); auto r1_ = __builtin_amdgcn_permlane32_swap(a1_, b1_, false, false); \
    u32x4 w_ = {r0_[0], r1_[0], r0_[1], r1_[1]}; OUT = *reinterpret_cast<bf16x8*>(&w_); } while (0)
constexpr int F_KN0 = 3 * 8192, F_KR0 = F_KN0 + 3 * 8192, F_RED = F_KR0 + 3 * 4096;
template <int DQK, class QF>
__device__ __forceinline__ void attn_body_fast(QF qf, const bf16_t* __restrict__ Kg, int kld, const bf16_t* __restrict__ Krg,
                                               const bf16_t* __restrict__ Vg, int vld, int seq, bf16_t* __restrict__ Gout, char* lds) {
  const int tid = opaque_tid(), wid = uni(tid >> 6), lane = tid & 63, r32 = lane & 31, hi = lane >> 5;
  LAS unsigned char* L = (LAS unsigned char*)lds;
  f32x16 o0 = {}, o1 = {}; float l0 = 0.f, l1 = 0.f;
  const int vb0 = (int)(uintptr_t)lds + v_rd_base(lane);
  int kn_a[4], kr_a[2];
#pragma unroll
  for (int d0 = 0; d0 < 4; ++d0) kn_a[d0] = F_KN0 + r32 * 128 + (((d0 * 2 + hi) ^ ((r32 >> 1) & 7)) << 4);
#pragma unroll
  for (int d0 = 0; d0 < 2; ++d0) kr_a[d0] = F_KR0 + r32 * 64 + (((d0 * 2 + hi) ^ ((r32 >> 2) & 3)) << 4);
  unsigned voffV, voffK, voffR = 0;
  { const int b = wid * 1024 + lane * 16;
    { const int sub = b >> 9, k = (sub >> 1) * 8 + ((b & 511) >> 6), c = (sub & 1) * 32 + ((b & 63) >> 1); voffV = (unsigned)(k * vld + c) * 2u; }
    { const int row = b >> 7, c = ((b & 127) >> 4) ^ ((row >> 1) & 7); voffK = (unsigned)(row * kld + c * 8) * 2u; }
    if (DQK == 96) { const int row = (b & 4095) >> 6, c = ((b & 63) >> 4) ^ ((row >> 2) & 3); voffR = (unsigned)(row * 32 + c * 8) * 2u; } }
  const char* bV = (const char*)Vg; const char* bK = (const char*)Kg; const char* bR = (const char*)Krg;
  const int stV = 64 * vld * 2, stK = 64 * kld * 2;
#define DMA(slot) do { \
    __builtin_amdgcn_global_load_lds((const unsigned*)(bV + voffV), (LAS unsigned*)(L + (slot) * 8192 + wid * 1024), 16, 0, 0); bV += stV; \
    __builtin_amdgcn_global_load_lds((const unsigned*)(bK + voffK), (LAS unsigned*)(L + F_KN0 + (slot) * 8192 + wid * 1024), 16, 0, 0); bK += stK; \
    if (DQK == 96) { if (wid < 4) __builtin_amdgcn_global_load_lds((const unsigned*)(bR + voffR), (LAS unsigned*)(L + F_KR0 + (slot) * 4096 + wid * 1024), 16, 0, 0); bR += 64 * 32 * 2; } } while (0)
#define LANDED() do { asm volatile("s_waitcnt vmcnt(0)" ::: "memory"); __syncthreads(); } while (0)
#define QK(N0, N1, slot) do { N0 = f32x16{}; N1 = f32x16{}; bf16x8 kf0_[DQK / 16], kf1_[DQK / 16]; \
    _Pragma("unroll") for (int d0 = 0; d0 < 4; ++d0) { kf0_[d0] = *(const LAS bf16x8*)(L + kn_a[d0] + (slot) * 8192); kf1_[d0] = *(const LAS bf16x8*)(L + kn_a[d0] + (slot) * 8192 + 4096); } \
    if (DQK == 96) { _Pragma("unroll") for (int d0 = 0; d0 < 2; ++d0) { kf0_[DQK / 16 - 2 + d0] = *(const LAS bf16x8*)(L + kr_a[d0] + (slot) * 4096); kf1_[DQK / 16 - 2 + d0] = *(const LAS bf16x8*)(L + kr_a[d0] + (slot) * 4096 + 2048); } } \
    SBAR();   \
    _Pragma("unroll") for (int d0 = 0; d0 < DQK / 16; ++d0) { \
      N0 = __builtin_amdgcn_mfma_f32_32x32x16_bf16(kf0_[d0], qr[d0], N0, 0, 0, 0); N1 = __builtin_amdgcn_mfma_f32_32x32x16_bf16(kf1_[d0], qr[d0], N1, 0, 0, 0); } } while (0)
#define PKP(P, B) (bf16x8)__builtin_bit_cast(bf16x8, (u32x4){cvtpk_s(P[B + 0], P[B + 1]), cvtpk_s(P[B + 2], P[B + 3]), cvtpk_s(P[B + 4], P[B + 5]), cvtpk_s(P[B + 6], P[B + 7])})
#define FIN(P0, P1) do { _Pragma("unroll") for (int r = 0; r < 16; ++r) { P1[r] = __builtin_amdgcn_exp2f(P1[r]); if (r & 1) l1 += P1[r]; else l0 += P1[r]; } \
    pa0 = PKP(P0, 0); pa1 = PKP(P0, 8); pa2 = PKP(P1, 0); pa3 = PKP(P1, 8); } while (0)
#define PK(L_, H_) (bf16x8){L_[0], L_[1], L_[2], L_[3], H_[0], H_[1], H_[2], H_[3]}
#define PVX(slot, N0, DOEXP) do { const int vb = vb0; \
    s16x4 a0 = tr_read<v_rd_off(0, 0, 0) + (slot) * 8192>(vb), a1 = tr_read<v_rd_off(0, 0, 1) + (slot) * 8192>(vb), a2 = tr_read<v_rd_off(0, 1, 0) + (slot) * 8192>(vb), a3 = tr_read<v_rd_off(0, 1, 1) + (slot) * 8192>(vb); \
    s16x4 a4 = tr_read<v_rd_off(0, 2, 0) + (slot) * 8192>(vb), a5 = tr_read<v_rd_off(0, 2, 1) + (slot) * 8192>(vb), a6 = tr_read<v_rd_off(0, 3, 0) + (slot) * 8192>(vb), a7 = tr_read<v_rd_off(0, 3, 1) + (slot) * 8192>(vb); \
    s16x4 b0 = tr_read<v_rd_off(1, 0, 0) + (slot) * 8192>(vb), b1 = tr_read<v_rd_off(1, 0, 1) + (slot) * 8192>(vb), b2 = tr_read<v_rd_off(1, 1, 0) + (slot) * 8192>(vb), b3 = tr_read<v_rd_off(1, 1, 1) + (slot) * 8192>(vb); \
    s16x4 b4 = tr_read<v_rd_off(1, 2, 0) + (slot) * 8192>(vb), b5 = tr_read<v_rd_off(1, 2, 1) + (slot) * 8192>(vb), b6 = tr_read<v_rd_off(1, 3, 0) + (slot) * 8192>(vb), b7 = tr_read<v_rd_off(1, 3, 1) + (slot) * 8192>(vb); \
    if (DOEXP) { _Pragma("unroll") for (int r = 0; r < 16; ++r) { N0[r] = __builtin_amdgcn_exp2f(N0[r]); if (r & 1) l1 += N0[r]; else l0 += N0[r]; } } \
    asm volatile("s_waitcnt lgkmcnt(0)" : "+v"(a0), "+v"(a1), "+v"(a2), "+v"(a3), "+v"(a4), "+v"(a5), "+v"(a6), "+v"(a7), \
                 "+v"(b0), "+v"(b1), "+v"(b2), "+v"(b3), "+v"(b4), "+v"(b5), "+v"(b6), "+v"(b7) :: "memory");   \
    o0 = __builtin_amdgcn_mfma_f32_32x32x16_bf16(pa0, PK(a0, a1), o0, 0, 0, 0); o1 = __builtin_amdgcn_mfma_f32_32x32x16_bf16(pa0, PK(b0, b1), o1, 0, 0, 0); \
    o0 = __builtin_amdgcn_mfma_f32_32x32x16_bf16(pa1, PK(a2, a3), o0, 0, 0, 0); o1 = __builtin_amdgcn_mfma_f32_32x32x16_bf16(pa1, PK(b2, b3), o1, 0, 0, 0); \
    o0 = __builtin_amdgcn_mfma_f32_32x32x16_bf16(pa2, PK(a4, a5), o0, 0, 0, 0); o1 = __builtin_amdgcn_mfma_f32_32x32x16_bf16(pa2, PK(b4, b5), o1, 0, 0, 0); \
    o0 = __builtin_amdgcn_mfma_f32_32x32x16_bf16(pa3, PK(a6, a7), o0, 0, 0, 0); o1 = __builtin_amdgcn_mfma_f32_32x32x16_bf16(pa3, PK(b6, b7), o1, 0, 0, 0); } while (0)
#define PAIR(SP, SC, SN) do { \
    SBAR(); DMA(SN); SBAR(); QK(sB0, sB1, SC); FIN(sA0, sA1); SBAR(); PVX(SP, sB0, 1); SBAR(); LANDED(); \
    SBAR(); DMA(SP); SBAR(); QK(sA0, sA1, SN); FIN(sB0, sB1); SBAR(); PVX(SC, sA0, 1); SBAR(); LANDED(); } while (0)
  f32x16 sA0, sA1, sB0, sB1; bf16x8 pa0, pa1, pa2, pa3; const int NT = seq / 64;
  DMA(0); DMA(1);
  bf16x8 qr[DQK / 16];
  const float bound = qf(qr);
  LANDED();
  if (!(bound < 60.f)) {
    attn_body<DQK>(qr, Kg, kld, Krg, Vg, vld, seq, Gout, lds, true);
    return;
  }
  QK(sA0, sA1, 0);
#pragma unroll
  for (int r = 0; r < 16; ++r) { sA0[r] = __builtin_amdgcn_exp2f(sA0[r]); l0 += sA0[r]; }
  int j = 1, ph = 0;
  for (;;) {
    if (j + 1 >= NT) break;
    PAIR(0, 1, 2); j += 2; ph = 1;
    if (j + 1 >= NT) break;
    PAIR(2, 0, 1); j += 2; ph = 2;
    if (j + 1 >= NT) break;
    PAIR(1, 2, 0); j += 2; ph = 0;
  }
#define TAIL(SP, SC) do { SBAR(); QK(sB0, sB1, SC); FIN(sA0, sA1); SBAR(); PVX(SP, sB0, 1); SBAR(); FIN(sB0, sB1); SBAR(); GLOADS(); SBAR(); PVX(SC, sB0, 0); } while (0)
  bf16_t* Gw = Gout + (size_t)(wid * 32) * 1024 + r32;
  unsigned short gq0[16], gq1[16];
#define GLOADS() do { _Pragma("unroll") for (int r = 0; r < 16; ++r) { const bf16_t* gp_ = Gw + (size_t)crow(r, hi) * 1024; gq0[r] = gp_[0]; gq1[r] = gp_[32]; } } while (0)
  if (ph == 0) TAIL(0, 1); else if (ph == 1) TAIL(2, 0); else TAIL(1, 2);
  float l_reg = l0 + l1;
  { auto rr = __builtin_amdgcn_permlane32_swap(__float_as_uint(l_reg), __float_as_uint(l_reg), false, false);
    l_reg = __uint_as_float(rr[0]) + __uint_as_float(rr[1]); }
  float* li_l = (float*)(lds + F_RED + 64) + wid * 32;
  if (hi == 0) li_l[r32] = l_reg; asm volatile("s_waitcnt lgkmcnt(0)" ::: "memory");
#pragma unroll
  for (int r = 0; r < 16; ++r) { const int orow = crow(r, hi); const float rl = __builtin_amdgcn_rcpf(li_l[orow]);
    bf16_t* gp = Gw + (size_t)orow * 1024; const float g0 = bf2f(gq0[r]), g1 = bf2f(gq1[r]);
    gp[0] = f2bf(o0[r] * rl * g0); gp[32] = f2bf(o1[r] * rl * g1); }
  __syncthreads();
#undef DMA
#undef LANDED
#undef QK
#undef PKP
#undef FIN
#undef PK
#undef PVX
#undef PAIR
#undef TAIL
#undef GLOADS
}

__device__ void attn_phase(const Params& p, int l, char* lds, bool live = true) {
  const int tid = opaque_tid(), wid = uni(tid >> 6), lane = tid & 63, r32 = lane & 31, hi = lane >> 5;
  bf16_t* G = (bf16_t*)(p.ws + OFF_G);
  const bf16_t* KVA = (const bf16_t*)(p.ws + OFF_H);
  const bf16_t* KR = (const bf16_t*)(p.ws + OFF_KROPE);
  const bf16_t* QB = (const bf16_t*)(p.ws + OFF_QB);
  const bf16_t* KB = (const bf16_t*)(p.ws + OFF_KB);
  const bf16_t* VB = (const bf16_t*)(p.ws + OFF_VB);
  const bf16_t* QLAT = (const bf16_t*)(p.ws + OFF_QLAT);
  const float* SSQQ = (const float*)(p.ws + OFF_SSQQ);
  const float2* ROPE = (const float2*)(p.ws + OFF_ROPE);
  const bf16_t* WTUQ = (const bf16_t*)(p.ws + OFF_WTUQ) + (size_t)l * 768 * 256;
  int staged_h = -1;
  for (int it = blockIdx.x; it < 2048; it += gridDim.x) {
    const int step = it >> 8, w = it & 255, cls = step >> 1, sub = step & 1, x = w & 7, j = w >> 3;
    const bool sample = cls < 2, mla = (cls & 1) == 0;
    int bh, qblk;
    if (sample) { bh = sub * 8 + x; qblk = j; } else { bh = sub * 16 + x * 2 + (j >> 4); qblk = j & 15; }
    const int b = bh >> 3, h = bh & 7;
    const int S = sample ? 8192 : 4096;
    const int tseq = sample ? TOKP + b * 8192 : b * 4096;
    const int t0 = tseq + qblk * 256;
    const int trow = t0 + wid * 32 + r32;
    if (mla) {
      const int kmi = (l * 6 + (sample ? 4 + b : b)) * 8 + h;
      const float kmx = __uint_as_float(((const unsigned*)(p.ws + OFF_KMAX))[kmi]) + __uint_as_float(((const unsigned*)(p.ws + OFF_BAR))[3584 + kmi]);
      const int spos = qblk * 256 + wid * 32 + r32;
      const bool need_w = (h != staged_h); staged_h = h;
      auto qf = [=](bf16x8 (&qr)[6]) -> float {
        LAS unsigned char* Lw = (LAS unsigned char*)lds + 65536;
        const f32x4 sq = *(const f32x4*)(SSQQ + (size_t)trow * 4);
        if (need_w) { const char* wbase = (const char*)(WTUQ + (size_t)h * 96 * 256);
#pragma unroll
          for (int i = 0; i < 6; ++i) { const int pc = wid * 6 + i, row = pc * 2 + (lane >> 5), c = (lane & 31) ^ (row & 31);
            __builtin_amdgcn_global_load_lds((const unsigned*)(wbase + (unsigned)((row * 256 + c * 8) * 2)), (LAS unsigned*)(Lw + pc * 1024), 16, 0, 0); } }
        const bf16_t* qlp = QLAT + (size_t)trow * 256 + hi * 8;
        if (need_w) { asm volatile("s_waitcnt vmcnt(0)" ::: "memory"); __syncthreads(); }
        f32x16 c0 = {}, c1 = {}, c2 = {};
#pragma unroll 8
        for (int ks = 0; ks < 16; ++ks) { const int ao = r32 * 512 + (((ks * 2 + hi) ^ r32) << 4);
          const bf16x8 bk = *(const bf16x8*)(qlp + ks * 16);
          const bf16x8 a0 = *(const LAS bf16x8*)(Lw + ao), a1 = *(const LAS bf16x8*)(Lw + ao + 16384), a2 = *(const LAS bf16x8*)(Lw + ao + 32768);
          c0 = __builtin_amdgcn_mfma_f32_32x32x16_bf16(a0, bk, c0, 0, 0, 0);
          c1 = __builtin_amdgcn_mfma_f32_32x32x16_bf16(a1, bk, c1, 0, 0, 0);
          c2 = __builtin_amdgcn_mfma_f32_32x32x16_bf16(a2, bk, c2, 0, 0, 0);
        }
        const float rstd = rsqrtf((sq[0] + sq[1] + sq[2] + sq[3]) * (1.f / 256.f) + EPS) * C_MLA;
        float qn = 0.f;
#pragma unroll
        for (int r = 0; r < 16; ++r) { c0[r] *= rstd; c1[r] *= rstd; c2[r] *= rstd; qn += c0[r] * c0[r] + c1[r] * c1[r] + c2[r] * c2[r]; }
        const float2* rp = ROPE + (size_t)spos * 16;
#pragma unroll
        for (int r = 0; r < 8; ++r) { const float2 cs = rp[crow(r, hi)]; const float a = c2[r], bq2 = c2[r + 8];
          c2[r] = a * cs.x - bq2 * cs.y; c2[r + 8] = a * cs.y + bq2 * cs.x; }
        PK4(c0, 0, qr[0]); PK4(c0, 8, qr[1]); PK4(c1, 0, qr[2]); PK4(c1, 8, qr[3]); PK4(c2, 0, qr[4]); PK4(c2, 8, qr[5]);
        qn += __shfl_xor(qn, 32);
#pragma unroll
        for (int off = 1; off < 32; off <<= 1) qn = fmaxf(qn, __shfl_xor(qn, off));
        float* red = (float*)(lds + F_RED);
        if (lane == 0) red[wid] = qn;
        __syncthreads();
        float qmx = red[0];
#pragma unroll
        for (int i = 1; i < 8; ++i) qmx = fmaxf(qmx, red[i]);
        return sqrtf(qmx * kmx) * 1.05f;
      };
      const size_t kvrow0 = (size_t)hm_row<8>(tseq, h);
      attn_body_fast<96>(qf, KVA + kvrow0 * 128, 128, KR + (size_t)tseq * 32, KVA + kvrow0 * 128 + 64, 128, S, G + (size_t)t0 * 1024 + h * 64, lds);
    } else {
      const size_t kvrow0 = (size_t)hm_row<2>(tseq, h >> 2);
      const float* gqn = p.g_qn + l * 64; const float* gkn = p.g_kn + l * 64;
      auto qf = [=](bf16x8 (&qr)[4]) -> float {
        const bf16_t* qp = QB + (size_t)trow * 512 + h * 64 + hi * 8;
#pragma unroll
        for (int d0 = 0; d0 < 4; ++d0) qr[d0] = *(const bf16x8*)(qp + d0 * 16);
        float gq = fabsf(gqn[lane]), gk = fabsf(gkn[lane]);
#pragma unroll
        for (int off = 1; off < 64; off <<= 1) { gq = fmaxf(gq, __shfl_xor(gq, off)); gk = fmaxf(gk, __shfl_xor(gk, off)); }
        return 64.f * C_GQA * gq * gk * 1.05f;
      };
      attn_body_fast<64>(qf, KB + kvrow0 * 64, 64, nullptr, VB + kvrow0 * 64, 64, S, G + (size_t)t0 * 1024 + 512 + h * 64, lds);
    }
  }
}

#define XB_TMO      128
#define XB_XCNT(j)  (256  + 64 * (j))
#define XB_XSUB(j)  (1280 + 64 * (j))
#define XB_XGEN(j)  (2304 + 64 * (j))
#define XB_TOP      3328
#define XB_TOPGEN   3392
#define XCD_BAR_WORDS 3456
#define XB_SPIN_CAP (1u << 18)

__device__ __forceinline__ unsigned xb_ld(unsigned* p)              { return __hip_atomic_load(p, __ATOMIC_RELAXED, __HIP_MEMORY_SCOPE_AGENT); }
__device__ __forceinline__ unsigned xb_add(unsigned* p, unsigned v) { return __hip_atomic_fetch_add(p, v, __ATOMIC_RELAXED, __HIP_MEMORY_SCOPE_AGENT); }
__device__ __forceinline__ unsigned xb_xcc_id() { return (unsigned)__builtin_amdgcn_s_getreg((3 << 11) | 20) & 0xFu; }
#define XB_SPIN(cond, bar) do { unsigned _sp = 0; while (cond) { __builtin_amdgcn_s_sleep(1); \
    if ((++_sp & 255u) == 0u) { if (xb_ld(&(bar)[XB_TMO])) break; if (_sp > XB_SPIN_CAP) { atomicAdd(&(bar)[XB_TMO], 1u); break; } } } } while (0)

struct XcdBarrier {
    unsigned* bar; unsigned x;
    volatile LAS unsigned* st;
};

__device__ __forceinline__ XcdBarrier xcd_barrier_post(unsigned* bar, volatile LAS unsigned* st) {
    XcdBarrier b; b.bar = bar; b.x = xb_xcc_id(); b.st = st;
    if (threadIdx.x == 0) (void)xb_add(&bar[XB_XCNT(b.x)], 1u);
    return b;
}
__device__ __forceinline__ void xcd_barrier_complete(unsigned* bar, unsigned x, unsigned& nloc, unsigned& nx) {
    const unsigned G = gridDim.x * gridDim.y * gridDim.z;
    unsigned sum, cnt, mine, sp = 0u;
    for (;;) {
        sum = 0u; cnt = 0u; mine = 0u;
#pragma unroll
        for (unsigned j = 0; j < 16; ++j) { const unsigned c = xb_ld(&bar[XB_XCNT(j)]); sum += c; cnt += (c > 0u) ? 1u : 0u; mine = (j == x) ? c : mine; }
        if (sum == G) break;
        __builtin_amdgcn_s_sleep(1);
        if ((++sp & 255u) == 0u) { if (xb_ld(&bar[XB_TMO])) break; if (sp > XB_SPIN_CAP) { atomicAdd(&bar[XB_TMO], 1u); break; } }
    }
    nloc = mine > 0u ? mine : 1u; nx = cnt > 0u ? cnt : 1u;
}

__device__ __forceinline__ void xcd_barrier(const XcdBarrier& b) {
    asm volatile("s_waitcnt vmcnt(0)" ::: "memory");
    __syncthreads();
    if (threadIdx.x == 0) {
        unsigned* bar = b.bar; asm volatile("" : "+s"(bar));
        __builtin_amdgcn_s_waitcnt(0);
        unsigned nloc = b.st[0], nx = b.st[1];
        if (nloc == 0u) { xcd_barrier_complete(bar, b.x, nloc, nx); b.st[0] = nloc; b.st[1] = nx; }
        const unsigned old = xb_add(&bar[XB_XSUB(b.x)], 1u);
        const unsigned gen = old / nloc;
        if (old + 1u == (gen + 1u) * nloc) {
            __builtin_amdgcn_fence(__ATOMIC_RELEASE, "agent");
            asm volatile("s_waitcnt vmcnt(0)" ::: "memory");
            const unsigned og = xb_add(&bar[XB_TOP], 1u);
            const unsigned tg = og / nx;
            if (og + 1u == (tg + 1u) * nx) xb_add(&bar[XB_TOPGEN], 1u);
            else XB_SPIN(xb_ld(&bar[XB_TOPGEN]) == tg, bar);
            __builtin_amdgcn_fence(__ATOMIC_ACQUIRE, "agent");
            xb_add(&bar[XB_XGEN(b.x)], 1u);
            asm volatile("s_waitcnt vmcnt(0)" ::: "memory");
        } else {
            XB_SPIN(xb_ld(&bar[XB_XGEN(b.x)]) == gen, bar);
            __builtin_amdgcn_fence(__ATOMIC_ACQUIRE, "agent");
            asm volatile("s_waitcnt vmcnt(0)" ::: "memory");
        }
    }
    __syncthreads();
}


__global__ void __launch_bounds__(NTHR) mk_forward(Params p) {
  extern __shared__ __attribute__((aligned(16))) char smem[];
  cg::grid_group grid = cg::this_grid();
  const bool never = (p.out == nullptr);
  unsigned* bar = (unsigned*)(p.ws + OFF_BAR);
  volatile LAS unsigned* xst = (volatile LAS unsigned*)((LAS unsigned char*)smem + LDS_RING);
  if (threadIdx.x < 4) xst[threadIdx.x] = 0u;
  if (blockIdx.x == 0) for (int i = threadIdx.x; i < 4096; i += NTHR) bar[i] = 0u;
  prologue_phase(p, smem);
  grid.sync();
  (void)xcd_barrier_post(bar, xst);
#define GRID_SYNC() do { XcdBarrier xb_; unsigned* bar_ = (unsigned*)(p.ws + OFF_BAR); asm volatile("" : "+s"(bar_)); unsigned x_ = xb_xcc_id(); asm volatile("" : "+s"(x_)); \
    xb_.bar = bar_; xb_.x = x_; xb_.st = (volatile LAS unsigned*)((LAS unsigned char*)smem + LDS_RING); xcd_barrier(xb_); } while (0)
  norm_phase(p, 0, 0);
  sw_phase(p);
  GRID_SYNC();
  for (int l = 0; l < NLAYER; ++l) {
    { pg8::Gemm g{(const bf16_t*)(p.ws + OFF_H), (const bf16_t*)(p.ws + OFF_WTIN) + (size_t)l * NPAD * 1024, NTOK, NPAD, 1024};
      pg8::StaticOrder S; S.init(NTOK, NPAD, (int)gridDim.x, (int)blockIdx.x);
      EpiInProj E{p.ws, p.g_qn + l * 64, p.g_kn + l * 64, (const float*)(p.ws + OFF_SW) + (size_t)l * 6 * NPAD};
      pg8::gemm_phase<EpiInProj, pg8::StaticOrder, true, true>((PG8_LAS unsigned char*)smem, g, S, E);
#if PROBE_GEMM2
      __syncthreads();
      pg8::gemm_phase<EpiInProj, pg8::StaticOrder, true, true>((PG8_LAS unsigned char*)smem, g, S, E);
#endif
    }
    GRID_SYNC();
    { pg8::Gemm g{(const bf16_t*)(p.ws + OFF_KVLAT), (const bf16_t*)(p.ws + OFF_WTUKV) + (size_t)l * 1024 * 128, NTOK, 1024, 128};
      pg8::StaticOrder S; S.init(NTOK, 1024, (int)gridDim.x, (int)blockIdx.x);
      EpiKvUp E{p.ws, l};
      pg8::gemm_phase<EpiKvUp, pg8::StaticOrder, true, true>((PG8_LAS unsigned char*)smem, g, S, E); }
    GRID_SYNC();
    if (PROBE_ATTN2) attn_phase(p, l, smem, never);
    attn_phase(p, l, smem);
    GRID_SYNC();
    { pg8::Gemm g{(const bf16_t*)(p.ws + OFF_G), (const bf16_t*)(p.ws + OFF_WTOUT) + (size_t)l * 1024 * 1024, NTOK, 1024, 1024};
      pg8::StaticOrder S; S.init(NTOK, 1024, (int)gridDim.x, (int)blockIdx.x);
      EpiOutProj E{p.x_prompt, p.x_sample, p.out, (const float*)(p.ws + OFF_MOD) + (size_t)l * 6 * 3072, l == 0 ? 1 : 0,
                   p.g_norm + (l + 1 < NLAYER ? l + 1 : l) * DM, (bf16_t*)(p.ws + OFF_H), (float*)(p.ws + OFF_SSQX), l + 1 < NLAYER ? 1 : 0};
      pg8::gemm_phase<EpiOutProj, pg8::StaticOrder, true, true>((PG8_LAS unsigned char*)smem, g, S, E); }
    GRID_SYNC();
  }
  norm_phase(p, 0, 1);
}

extern "C" void kernel_launch(void* const* d_in, const int* in_sizes, int n_in, void* d_out, int out_size, void* d_ws, size_t ws_size, hipStream_t stream) {
  static int grid_blocks = 0;
  if (!grid_blocks) {
    if (n_in != 16 || out_size != NTOK * DM || ws_size < WS_END) {
      fprintf(stderr, "kernel_launch: unexpected shapes n_in %d out %d ws %zu (need %zu)\n", n_in, out_size, ws_size, (size_t)WS_END); return; }
    if (hipFuncSetAttribute((const void*)mk_forward, hipFuncAttributeMaxDynamicSharedMemorySize, LDS_BYTES) != hipSuccess) {
      fprintf(stderr, "kernel_launch: hipFuncSetAttribute failed\n"); return; }
    int dev = 0, cus = 0, per_cu = 0;
    hipGetDevice(&dev);
    hipDeviceGetAttribute(&cus, hipDeviceAttributeMultiprocessorCount, dev);
    hipOccupancyMaxActiveBlocksPerMultiprocessor(&per_cu, mk_forward, NTHR, LDS_BYTES);
    if (per_cu < 1) { fprintf(stderr, "kernel_launch: occupancy 0\n"); return; }
    grid_blocks = cus;
  }
  Params p{};
  p.x_prompt = (const float*)d_in[0]; p.x_sample = (const float*)d_in[1]; p.c_prompt = (const float*)d_in[2]; p.c_sample = (const float*)d_in[3];
  p.w_ada = (const float*)d_in[4]; p.b_ada = (const float*)d_in[5]; p.g_norm = (const float*)d_in[6]; p.w_in = (const float*)d_in[7];
  p.g_qa = (const float*)d_in[8]; p.w_uq = (const float*)d_in[9]; p.g_kva = (const float*)d_in[10]; p.w_ukv = (const float*)d_in[11];
  p.g_qn = (const float*)d_in[12]; p.g_kn = (const float*)d_in[13]; p.w_out = (const float*)d_in[14]; p.g_final = (const float*)d_in[15];
  p.out = (float*)d_out; p.ws = (char*)d_ws;
  void* args[] = {&p};
  hipError_t e = hipLaunchCooperativeKernel((const void*)mk_forward, dim3(grid_blocks), dim3(NTHR), args, LDS_BYTES, stream);
  if (e != hipSuccess) fprintf(stderr, "cooperative launch failed: %s (grid %d)\n", hipGetErrorString(e), grid_blocks);
}
```

```cpp
#include <hip/hip_runtime.h>
#include <hip/hip_cooperative_groups.h>
#include <cstdio>
#include <cstdint>
namespace cg = cooperative_groups;
#ifndef PROBE_ATTN2
#define PROBE_ATTN2 0
#endif
#ifndef PROBE_GEMM2
#define PROBE_GEMM2 0
#endif
#ifndef PROBE_MISC2
#define PROBE_MISC2 0
#endif

typedef unsigned short bf16_t;
using bf16x8 = __attribute__((ext_vector_type(8))) short;
using s16x4  = __attribute__((ext_vector_type(4))) short;
using f32x16 = __attribute__((ext_vector_type(16))) float;
using f32x4  = __attribute__((ext_vector_type(4))) float;
using u32x4  = __attribute__((ext_vector_type(4))) unsigned;
using u32x2  = __attribute__((ext_vector_type(2))) unsigned;

constexpr int DM = 1024, NTOK = 32768, TOKP = 16384, NLAYER = 4, NPROJ = 2208, NPAD = 2304;
constexpr float EPS = 1e-6f;
constexpr float LOG2E = 1.4426950408889634f;
constexpr float C_GQA = 0.125f * LOG2E, C_MLA = 0.10206207261596575f * LOG2E;
constexpr int NTHR = 512;
constexpr size_t OFF_WTIN  = 0;
constexpr size_t OFF_WTUQ  = OFF_WTIN  + (size_t)4 * 2304 * 1024 * 2;
constexpr size_t OFF_WTUKV = OFF_WTUQ  + (size_t)4 * 768 * 256 * 2;
constexpr size_t OFF_WTOUT = OFF_WTUKV + (size_t)4 * 1024 * 128 * 2;
constexpr size_t OFF_MOD   = OFF_WTOUT + (size_t)4 * 1024 * 1024 * 2;
constexpr size_t OFF_ROPE  = OFF_MOD   + (size_t)4 * 6 * 3072 * 4;
constexpr size_t OFF_SSQQ  = OFF_ROPE  + (size_t)8192 * 16 * 8;
constexpr size_t OFF_SSQKV = OFF_SSQQ  + (size_t)NTOK * 4 * 4;
constexpr size_t OFF_G     = OFF_SSQKV + (size_t)NTOK * 4 * 4;
constexpr size_t OFF_QB    = OFF_G     + (size_t)NTOK * 1024 * 2;
constexpr size_t OFF_KB    = OFF_QB    + (size_t)NTOK * 512 * 2;
constexpr size_t OFF_VB    = OFF_KB    + (size_t)NTOK * 128 * 2;
constexpr size_t OFF_KROPE = OFF_VB    + (size_t)NTOK * 128 * 2;
constexpr size_t OFF_QLAT  = OFF_KROPE + (size_t)NTOK * 32 * 2;
constexpr size_t OFF_KVLAT = OFF_QLAT  + (size_t)NTOK * 256 * 2;
constexpr size_t OFF_H     = OFF_KVLAT + (size_t)NTOK * 128 * 2;
constexpr size_t OFF_KRSS  = OFF_H     + (size_t)NTOK * 1024 * 2;
constexpr size_t OFF_KMAX  = OFF_KRSS  + (size_t)NTOK * 4;
constexpr size_t OFF_BAR   = OFF_KMAX  + 1024;
constexpr size_t OFF_SSQX  = OFF_BAR   + 16384;
constexpr size_t OFF_SW    = OFF_SSQX  + (size_t)NTOK * 16 * 4;
constexpr size_t WS_END    = OFF_SW    + (size_t)4 * 6 * NPAD * 4;
constexpr int LDS_RING = 131072, LDS_BYTES = LDS_RING + 16;

struct Params {
  const float *x_prompt, *x_sample, *c_prompt, *c_sample, *w_ada, *b_ada, *g_norm, *w_in, *g_qa, *w_uq, *g_kva, *w_ukv, *g_qn, *g_kn, *w_out, *g_final;
  float* out; char* ws;
};

__device__ __forceinline__ unsigned cvtpk(float lo, float hi) { unsigned r; asm volatile("v_cvt_pk_bf16_f32 %0, %1, %2" : "=v"(r) : "v"(lo), "v"(hi)); return r; }
typedef __bf16 bf16x2_t __attribute__((ext_vector_type(2)));
typedef float f32x2_t __attribute__((ext_vector_type(2)));
__device__ __forceinline__ unsigned cvtpk_s(float lo, float hi) { f32x2_t v = {lo, hi}; bf16x2_t b = __builtin_convertvector(v, bf16x2_t); return __builtin_bit_cast(unsigned, b); }
__device__ __forceinline__ float bf2f(bf16_t v) { return __uint_as_float(((unsigned)v) << 16); }
__device__ __forceinline__ bf16_t f2bf(float f) { return (bf16_t)(cvtpk(f, f) & 0xffffu); }
__device__ __forceinline__ int crow(int r, int hi) { return (r & 3) + 8 * (r >> 2) + 4 * hi; }
#define SBAR() __builtin_amdgcn_sched_barrier(0)
#define LAS __attribute__((address_space(3)))
__device__ __forceinline__ int opaque_tid() { int t = threadIdx.x; asm volatile("" : "+v"(t)); return t; }
__device__ __forceinline__ int uni(int v) { return __builtin_amdgcn_readfirstlane(v); }

__device__ __forceinline__ void tok_info(int t, int& bb, int& s) {
  if (t < TOKP) { bb = t >> 12; s = t & 4095; } else { int u = t - TOKP; bb = 4 + (u >> 13); s = u & 8191; }
}
template <int NH> __device__ __forceinline__ int hm_row(int t, int h) {
  if (t < TOKP) { int b = t >> 12, s = t & 4095; return (b * NH + h) * 4096 + s; }
  int u = t - TOKP, b = u >> 13, s = u & 8191; return 4 * NH * 4096 + (b * NH + h) * 8192 + s;
}

__device__ __forceinline__ int in_srccol(int n) {
  if (n < 416) return n;
  if (n < 512) return -1;
  if (n < 1280) {
    const int q = n - 512, tq = q >> 8, p = q & 255, slot = (p >> 5) & 3, dim = (p >> 7) * 32 + (p & 31), lg = slot * 64 + dim;
    if (tq < 2) return 928 + tq * 256 + lg;
    return lg < 128 ? 1440 + lg : 1568 + (lg - 128);
  }
  if (n < 1792) return 416 + (n - 1280);
  return 1696 + (n - 1792);
}
__device__ __forceinline__ void transpose_item(const float* __restrict__ src, int ldn, int K, int k0, int n0, int mode, const float* __restrict__ gk,
                                               bf16_t* __restrict__ dst, float* lds) {
  const int tid = threadIdx.x, nn = tid & 63, kq = tid >> 6;
  const int sc = mode ? in_srccol(n0 + nn) : (n0 + nn);
#pragma unroll
  for (int i = 0; i < 8; ++i) {
    const int kk = kq + i * 8; float v = 0.f;
    if (sc >= 0) { v = src[(size_t)(k0 + kk) * ldn + sc]; if (gk) v *= gk[k0 + kk]; }
    lds[kk * 65 + nn] = v;
  }
  __syncthreads();
  const int kk2 = tid & 63;
#pragma unroll
  for (int i = 0; i < 8; ++i) { const int n2 = kq + i * 8; dst[(size_t)(n0 + n2) * K + k0 + kk2] = f2bf(lds[kk2 * 65 + n2]); }
  __syncthreads();
}

__device__ void prologue_phase(const Params& p, char* smem) {
  float* lds = (float*)smem;
  const int tid = threadIdx.x;
  bf16_t* WTIN = (bf16_t*)(p.ws + OFF_WTIN); bf16_t* WTUQ = (bf16_t*)(p.ws + OFF_WTUQ);
  bf16_t* WTUKV = (bf16_t*)(p.ws + OFF_WTUKV); bf16_t* WTOUT = (bf16_t*)(p.ws + OFF_WTOUT);
  for (int it = blockIdx.x; it < 4 * 912; it += gridDim.x) {
    const int l = it / 912, r = it % 912;
    if (r < 576) { const int kt = r / 36, nt = r % 36;
      transpose_item(p.w_in + (size_t)l * 1024 * NPROJ, NPROJ, 1024, kt * 64, nt * 64, 1, nullptr, WTIN + (size_t)l * NPAD * 1024, lds);
    } else if (r < 624) { const int q = r - 576, kt = q / 12, nt = q % 12;
      transpose_item(p.w_uq + (size_t)l * 256 * 768, 768, 256, kt * 64, nt * 64, 0, p.g_qa + l * 256, WTUQ + (size_t)l * 768 * 256, lds);
    } else if (r < 656) { const int q = r - 624, kt = q / 16, nt = q % 16;
      transpose_item(p.w_ukv + (size_t)l * 128 * 1024, 1024, 128, kt * 64, nt * 64, 0, p.g_kva + l * 128, WTUKV + (size_t)l * 1024 * 128, lds);
    } else { const int q = r - 656, kt = q / 16, nt = q % 16;
      transpose_item(p.w_out + (size_t)l * 1024 * 1024, 1024, 1024, kt * 64, nt * 64, 0, nullptr, WTOUT + (size_t)l * 1024 * 1024, lds);
    }
  }
  float* MOD = (float*)(p.ws + OFF_MOD);
  for (int it = blockIdx.x; it < 4 * 48; it += gridDim.x) {
    const int l = it / 48, n0 = (it % 48) * 64;
    float* sc = lds; float* red = lds + 6144;
    for (int i = tid; i < 6144; i += NTHR) { const int bb = i >> 10, k = i & 1023;
      const float c = bb < 4 ? p.c_prompt[bb * 1024 + k] : p.c_sample[(bb - 4) * 1024 + k];
      sc[i] = c / (1.f + __expf(-c)); }
    __syncthreads();
    const int g = tid >> 6, c = tid & 63;
    float a0 = 0, a1 = 0, a2 = 0, a3 = 0, a4 = 0, a5 = 0;
    const float* wp = p.w_ada + ((size_t)l * 1024 + g * 128) * 3072 + n0 + c;
#pragma unroll 16
    for (int k = 0; k < 128; ++k) { const float w = wp[(size_t)k * 3072]; const int kk = g * 128 + k;
      a0 += sc[kk] * w; a1 += sc[1024 + kk] * w; a2 += sc[2048 + kk] * w; a3 += sc[3072 + kk] * w; a4 += sc[4096 + kk] * w; a5 += sc[5120 + kk] * w; }
    red[(g * 6 + 0) * 64 + c] = a0; red[(g * 6 + 1) * 64 + c] = a1; red[(g * 6 + 2) * 64 + c] = a2;
    red[(g * 6 + 3) * 64 + c] = a3; red[(g * 6 + 4) * 64 + c] = a4; red[(g * 6 + 5) * 64 + c] = a5;
    __syncthreads();
    if (tid < 384) { const int bb = tid >> 6; float s = 0.f;
#pragma unroll
      for (int gg = 0; gg < 8; ++gg) s += red[(gg * 6 + bb) * 64 + c];
      MOD[(size_t)(l * 6 + bb) * 3072 + n0 + c] = s + p.b_ada[l * 3072 + n0 + c]; }
    __syncthreads();
  }
  if (blockIdx.x == 0 && tid < 192) ((unsigned*)(p.ws + OFF_KMAX))[tid] = 0u;
  float2* ROPE = (float2*)(p.ws + OFF_ROPE);
  for (int it = blockIdx.x; it < 256; it += gridDim.x) {
    const int e = it * 512 + tid, pos = e >> 4, i = e & 15, a = i >> 2, b = i & 3;
    const double pa = a == 0 ? 1.0 : a == 1 ? 0.1 : a == 2 ? 0.01 : 0.001;
    const double pb = b == 0 ? 1.0 : b == 1 ? 0.5623413251903491 : b == 2 ? 0.31622776601683794 : 0.17782794100389228;
    double rev = (double)pos * (pa * pb) * 0.15915494309189535;
    rev -= floor(rev);
    const float fr = (float)rev;
    ROPE[e] = make_float2(__builtin_amdgcn_cosf(fr), __builtin_amdgcn_sinf(fr));
  }
}

__device__ void norm_phase(const Params& p, int l, int mode) {
  const int tid = opaque_tid(), wid = uni(tid >> 6), lane = tid & 63;
  const float* MOD = (const float*)(p.ws + OFF_MOD);
  bf16_t* H = (bf16_t*)(p.ws + OFF_H);
#define XROW(r) ((mode == 0 && l == 0) ? ((r) < TOKP ? p.x_prompt + (size_t)(r) * DM : p.x_sample + (size_t)((r) - TOKP) * DM) : p.out + (size_t)(r) * DM)
  const int rstride = gridDim.x * 8;
  f32x4 v[4], nv[4];
  { const int r0 = blockIdx.x * 8 + wid; if (r0 < NTOK) { const float* xr = XROW(r0);
#pragma unroll
      for (int i = 0; i < 4; ++i) v[i] = ((const f32x4*)xr)[i * 64 + lane]; } }
  for (int row = blockIdx.x * 8 + wid; row < NTOK; row += rstride) {
    const int nrow = row + rstride;
    if (nrow < NTOK) { const float* xn = XROW(nrow);
#pragma unroll
      for (int i = 0; i < 4; ++i) nv[i] = ((const f32x4*)xn)[i * 64 + lane]; }
    float ss = 0.f;
#pragma unroll
    for (int i = 0; i < 4; ++i) ss += v[i][0] * v[i][0] + v[i][1] * v[i][1] + v[i][2] * v[i][2] + v[i][3] * v[i][3];
#pragma unroll
    for (int off = 32; off >= 1; off >>= 1) ss += __shfl_xor(ss, off);
    const float rstd = rsqrtf(ss * (1.f / 1024.f) + EPS);
    if (mode == 1) {
#pragma unroll
      for (int i = 0; i < 4; ++i) { const f32x4 g = ((const f32x4*)p.g_final)[i * 64 + lane];
        f32x4 o; o[0] = v[i][0] * rstd * g[0]; o[1] = v[i][1] * rstd * g[1]; o[2] = v[i][2] * rstd * g[2]; o[3] = v[i][3] * rstd * g[3];
        ((f32x4*)(p.out + (size_t)row * DM))[i * 64 + lane] = o; }
    } else {
      int bb, s; tok_info(row, bb, s);
      const float* md = MOD + (size_t)(l * 6 + bb) * 3072;
#pragma unroll
      for (int i = 0; i < 4; ++i) { const int ci = i * 64 + lane;
        const f32x4 g = ((const f32x4*)(p.g_norm + l * DM))[ci], sc = ((const f32x4*)(md + 1024))[ci];
        const float h0 = v[i][0] * g[0] * (1.f + sc[0]), h1 = v[i][1] * g[1] * (1.f + sc[1]);
        const float h2 = v[i][2] * g[2] * (1.f + sc[2]), h3 = v[i][3] * g[3] * (1.f + sc[3]);
        u32x2 w; w[0] = cvtpk(h0, h1); w[1] = cvtpk(h2, h3);
        *(u32x2*)(H + (size_t)row * DM + ci * 4) = w; }
      if (lane < 4) { f32x4 z = {0.f, 0.f, 0.f, 0.f}; if (lane == 0) z[0] = ss; ((f32x4*)(p.ws + OFF_SSQX))[(size_t)row * 4 + lane] = z; }
    }
#pragma unroll
    for (int i = 0; i < 4; ++i) v[i] = nv[i];
  }
#undef XROW
}


__device__ void sw_phase(const Params& p) {
  const int tid = opaque_tid(), wid = uni(tid >> 6), lane = tid & 63;
  const float* MOD = (const float*)(p.ws + OFF_MOD);
  const bf16_t* WTIN = (const bf16_t*)(p.ws + OFF_WTIN);
  float* SW = (float*)(p.ws + OFF_SW);
  for (int r = blockIdx.x * 8 + wid; r < 4 * NPAD; r += gridDim.x * 8) {
    const int l = r / NPAD, n = r % NPAD;
    const bf16_t* wr = WTIN + ((size_t)l * NPAD + n) * 1024 + lane * 16;
    const u32x4 w0 = *(const u32x4*)wr, w1 = *(const u32x4*)(wr + 8);
    float wf[16];
#pragma unroll
    for (int i = 0; i < 4; ++i) { wf[2 * i] = __uint_as_float(w0[i] << 16); wf[2 * i + 1] = __uint_as_float(w0[i] & 0xffff0000u);
      wf[8 + 2 * i] = __uint_as_float(w1[i] << 16); wf[8 + 2 * i + 1] = __uint_as_float(w1[i] & 0xffff0000u); }
#pragma unroll
    for (int bb = 0; bb < 6; ++bb) { const float* sh = MOD + (size_t)(l * 6 + bb) * 3072 + lane * 16; float a = 0.f;
#pragma unroll
      for (int i = 0; i < 4; ++i) { const f32x4 s4 = ((const f32x4*)sh)[i]; a += s4[0] * wf[4 * i] + s4[1] * wf[4 * i + 1] + s4[2] * wf[4 * i + 2] + s4[3] * wf[4 * i + 3]; }
#pragma unroll
      for (int off = 32; off >= 1; off >>= 1) a += __shfl_xor(a, off);
      if (lane == 0) SW[(size_t)(l * 6 + bb) * NPAD + n] = a; }
  }
}

#define GOFF(row, chunk) ((row) * 128 + ((((chunk)) ^ (((row) >> 1) & 7)) << 4))
enum { EPI_INPROJ = 0, EPI_KVUP = 1, EPI_OUT = 2 };

__device__ __forceinline__ void rope4(f32x4& x1, f32x4& x2, const float2* __restrict__ rp) {
  const f32x4 c01 = ((const f32x4*)rp)[0], c23 = ((const f32x4*)rp)[1];
  const float cs[4] = {c01[0], c01[2], c23[0], c23[2]}, sn[4] = {c01[1], c01[3], c23[1], c23[3]};
#pragma unroll
  for (int j = 0; j < 4; ++j) { const float a = x1[j], b = x2[j]; x1[j] = a * cs[j] - b * sn[j]; x2[j] = a * sn[j] + b * cs[j]; }
}
__device__ __forceinline__ void st_bf4(bf16_t* dst, const f32x4& v) { u32x2 w; w[0] = cvtpk(v[0], v[1]); w[1] = cvtpk(v[2], v[3]); *(u32x2*)dst = w; }
__device__ __forceinline__ float silu_f(float z) { return z * __builtin_amdgcn_rcpf(1.f + __builtin_amdgcn_exp2f(-1.4426950408889634f * z)); }

template <int EPI>
__device__ __forceinline__ void gemm_epilogue(const Params& p, int l, f32x4 (&acc)[4][4], int row0, int col0, int wr, int wc, int fr, int fq) {
  const int rbase = row0 + wr * 64 + fr;
  const int cw = col0 + wc * 64 + fq * 4;
  if constexpr (EPI == EPI_OUT) {
    const float* MOD = (const float*)(p.ws + OFF_MOD);
    int bb, s0; tok_info(row0, bb, s0);
    const float* gate = MOD + (size_t)(l * 6 + bb) * 3072 + 2048;
#pragma unroll
    for (int m = 0; m < 4; ++m) { const int t = rbase + m * 16;
      const float* xo = (l == 0) ? (t < TOKP ? p.x_prompt + (size_t)t * DM : p.x_sample + (size_t)(t - TOKP) * DM) : p.out + (size_t)t * DM;
#pragma unroll
      for (int n = 0; n < 4; ++n) { const int c = cw + n * 16; const f32x4 g = *(const f32x4*)(gate + c), x = *(const f32x4*)(xo + c);
        f32x4 o; o[0] = x[0] + g[0] * acc[m][n][0]; o[1] = x[1] + g[1] * acc[m][n][1]; o[2] = x[2] + g[2] * acc[m][n][2]; o[3] = x[3] + g[3] * acc[m][n][3];
        *(f32x4*)(p.out + (size_t)t * DM + c) = o; } }
  } else if constexpr (EPI == EPI_KVUP) {
    const float* SSQKV = (const float*)(p.ws + OFF_SSQKV);
    const float* KRSS = (const float*)(p.ws + OFF_KRSS);
    bf16_t* KVA = (bf16_t*)(p.ws + OFF_H);
    const int head = col0 >> 7;
    float kmx = 0.f;
#pragma unroll
    for (int m = 0; m < 4; ++m) { const int t = rbase + m * 16;
      const f32x4 sq = *(const f32x4*)(SSQKV + (size_t)t * 4);
      const float rstd = rsqrtf((sq[0] + sq[1] + sq[2] + sq[3]) * (1.f / 128.f) + EPS);
      bf16_t* dst = KVA + (size_t)hm_row<8>(t, head) * 128 + wc * 64 + fq * 4;
      float ss = 0.f;
#pragma unroll
      for (int n = 0; n < 4; ++n) { f32x4 v = acc[m][n] * rstd; ss += v[0] * v[0] + v[1] * v[1] + v[2] * v[2] + v[3] * v[3]; st_bf4(dst + n * 16, v); }
      ss += __shfl_xor(ss, 16); ss += __shfl_xor(ss, 32);
      kmx = fmaxf(kmx, ss + KRSS[t]); }
    if (wc == 0) {
#pragma unroll
      for (int off = 1; off < 16; off <<= 1) kmx = fmaxf(kmx, __shfl_xor(kmx, off));
      int bb, s0; tok_info(row0, bb, s0);
      if (fr == 0 && fq == 0) atomicMax((unsigned*)(p.ws + OFF_KMAX) + (l * 6 + bb) * 8 + head, __float_as_uint(kmx));
    }
  } else {
    const int ct = col0 >> 7;
    const float2* ROPE = (const float2*)(p.ws + OFF_ROPE);
    if (ct < 3) {
      bf16_t* dstb = ct < 2 ? (bf16_t*)(p.ws + OFF_QLAT) : (bf16_t*)(p.ws + OFF_KVLAT);
      const int ld = ct < 2 ? 256 : 128, cb = (ct < 2 ? col0 : 0) + wc * 64 + fq * 4;
      float* ssq = ct < 2 ? (float*)(p.ws + OFF_SSQQ) : (float*)(p.ws + OFF_SSQKV);
      const int sst = ct < 2 ? 4 : 2, sidx = (ct < 2 ? ct * 2 : 0) + wc;
#pragma unroll
      for (int m = 0; m < 4; ++m) { const int t = rbase + m * 16; float ss = 0.f;
#pragma unroll
        for (int n = 0; n < 4; ++n) { const f32x4 v = acc[m][n]; ss += v[0] * v[0] + v[1] * v[1] + v[2] * v[2] + v[3] * v[3]; st_bf4(dstb + (size_t)t * ld + cb + n * 16, v); }
        ss += __shfl_xor(ss, 16); ss += __shfl_xor(ss, 32);
        if (fq == 0) ssq[t * sst + sidx] = ss; }
    } else if (ct == 3) {
      if (wc == 0) { bf16_t* KR = (bf16_t*)(p.ws + OFF_KROPE);
#pragma unroll
        for (int m = 0; m < 4; ++m) { const int t = rbase + m * 16; int bb, s; tok_info(t, bb, s);
          f32x4 x1 = acc[m][0], x2 = acc[m][1]; rope4(x1, x2, ROPE + s * 16 + fq * 4);
          st_bf4(KR + (size_t)t * 32 + fq * 4, x1); st_bf4(KR + (size_t)t * 32 + 16 + fq * 4, x2); } }
    } else if (ct < 9) {
      const float* gv = (ct < 8 ? p.g_qn : p.g_kn) + l * 64;
      f32x4 g[4];
#pragma unroll
      for (int n = 0; n < 4; ++n) g[n] = *(const f32x4*)(gv + n * 16 + fq * 4);
#pragma unroll
      for (int m = 0; m < 4; ++m) { const int t = rbase + m * 16; int bb, s; tok_info(t, bb, s); float ss = 0.f;
#pragma unroll
        for (int n = 0; n < 4; ++n) { const f32x4 v = acc[m][n]; ss += v[0] * v[0] + v[1] * v[1] + v[2] * v[2] + v[3] * v[3]; }
        ss += __shfl_xor(ss, 16); ss += __shfl_xor(ss, 32);
        const float rstd = rsqrtf(ss * (1.f / 64.f) + EPS);
        f32x4 y[4];
#pragma unroll
        for (int n = 0; n < 4; ++n) { y[n][0] = acc[m][n][0] * rstd * g[n][0]; y[n][1] = acc[m][n][1] * rstd * g[n][1]; y[n][2] = acc[m][n][2] * rstd * g[n][2]; y[n][3] = acc[m][n][3] * rstd * g[n][3]; }
        rope4(y[0], y[1], ROPE + (s >> 6) * 16 + fq * 4);
        rope4(y[2], y[3], ROPE + (s & 63) * 16 + fq * 4);
        bf16_t* dst = ct < 8 ? (bf16_t*)(p.ws + OFF_QB) + (size_t)t * 512 + (col0 - 512) + wc * 64 + fq * 4
                             : (bf16_t*)(p.ws + OFF_KB) + (size_t)hm_row<2>(t, wc) * 64 + fq * 4;
#pragma unroll
        for (int n = 0; n < 4; ++n) st_bf4(dst + n * 16, y[n]); }
    } else if (ct == 9) {
#pragma unroll
      for (int m = 0; m < 4; ++m) { const int t = rbase + m * 16;
        bf16_t* dst = (bf16_t*)(p.ws + OFF_VB) + (size_t)hm_row<2>(t, wc) * 64 + fq * 4;
#pragma unroll
        for (int n = 0; n < 4; ++n) st_bf4(dst + n * 16, acc[m][n]); }
    } else {
      bf16_t* G = (bf16_t*)(p.ws + OFF_G);
#pragma unroll
      for (int m = 0; m < 4; ++m) { const int t = rbase + m * 16;
#pragma unroll
        for (int n = 0; n < 4; ++n) { f32x4 v; v[0] = silu_f(acc[m][n][0]); v[1] = silu_f(acc[m][n][1]); v[2] = silu_f(acc[m][n][2]); v[3] = silu_f(acc[m][n][3]);
          st_bf4(G + (size_t)t * 1024 + (cw - 1280) + n * 16, v); } }
    }
  }
}

template <int EPI>
__device__ __forceinline__ void gemm_tile(const Params& p, int l, const bf16_t* __restrict__ A, int lda, const bf16_t* __restrict__ Bt, int ldb, int K,
                                          int row0, int col0, char* lds, bool live = true) {
  const int tid = opaque_tid(), wid = uni(tid >> 6), lane = tid & 63, fr = lane & 15, fq = lane >> 4, wr = wid >> 1, wc = wid & 1;
  f32x4 acc[4][4];
#pragma unroll
  for (int m = 0; m < 4; ++m)
#pragma unroll
    for (int n = 0; n < 4; ++n) acc[m][n] = (f32x4){0.f, 0.f, 0.f, 0.f};
  const int sr = tid >> 3, sc = tid & 7;
  const bf16_t* Ag = A + (size_t)(row0 + sr) * lda + sc * 8;
  const bf16_t* Bg = Bt + (size_t)(col0 + sr) * ldb + sc * 8;
  u32x4 sa0, sa1, sa2, sa3, sb0, sb1;
#define GLOAD(kt) do { const int ko = (kt) * 64; sa0 = *(const u32x4*)(Ag + ko); sa1 = *(const u32x4*)(Ag + (size_t)64 * lda + ko); \
    sa2 = *(const u32x4*)(Ag + (size_t)128 * lda + ko); sa3 = *(const u32x4*)(Ag + (size_t)192 * lda + ko); \
    sb0 = *(const u32x4*)(Bg + ko); sb1 = *(const u32x4*)(Bg + (size_t)64 * ldb + ko); } while (0)
#define LWRITE(b) do { char* ab = lds + (b) * 49152; char* bbp = ab + 32768; \
    *(u32x4*)(ab + GOFF(sr, sc)) = sa0; *(u32x4*)(ab + GOFF(sr + 64, sc)) = sa1; *(u32x4*)(ab + GOFF(sr + 128, sc)) = sa2; *(u32x4*)(ab + GOFF(sr + 192, sc)) = sa3; \
    *(u32x4*)(bbp + GOFF(sr, sc)) = sb0; *(u32x4*)(bbp + GOFF(sr + 64, sc)) = sb1; } while (0)
  const int nk = K >> 6;
  GLOAD(0); LWRITE(0); __syncthreads();
  for (int kt = 0; kt < nk; ++kt) {
    const int cur = kt & 1;
    if (kt + 1 < nk) GLOAD(kt + 1);
    const char* ab = lds + cur * 49152; const char* bbp = ab + 32768;
#pragma unroll
    for (int kk = 0; kk < 2; ++kk) {
      bf16x8 af[4], bfr[4];
#pragma unroll
      for (int m = 0; m < 4; ++m) { const int row = wr * 64 + m * 16 + fr; af[m] = *(const bf16x8*)(ab + GOFF(row, kk * 4 + fq)); }
#pragma unroll
      for (int n = 0; n < 4; ++n) { const int row = wc * 64 + n * 16 + fr; bfr[n] = *(const bf16x8*)(bbp + GOFF(row, kk * 4 + fq)); }
#pragma unroll
      for (int m = 0; m < 4; ++m)
#pragma unroll
        for (int n = 0; n < 4; ++n) acc[m][n] = __builtin_amdgcn_mfma_f32_16x16x32_bf16(bfr[n], af[m], acc[m][n], 0, 0, 0);
    }
    if (kt + 1 < nk) LWRITE(cur ^ 1);
    __syncthreads();
  }
#undef GLOAD
#undef LWRITE
  if (live) gemm_epilogue<EPI>(p, l, acc, row0, col0, wr, wc, fr, fq);
}


namespace pg8 {
#define PG8_LAS __attribute__((address_space(3)))
typedef unsigned short bf16_t;
typedef short bf16x8 __attribute__((ext_vector_type(8)));
typedef float f32x4 __attribute__((ext_vector_type(4)));
typedef unsigned u32x4 __attribute__((ext_vector_type(4)));
constexpr int BM = 256, BK = 64, HALF = 128, HTB = HALF * BK * 2  , STAGE_BYTES = 8 * HTB, NXCD = 8, WGM = 8;

__host__ __device__ __forceinline__ int lds_byte(int r, int c) { const int st = (r >> 4) * 2 + (c >> 5), rr = r & 15, cc = c & 31, ob = rr * 64 + cc * 2; return st * 1024 + (ob ^ (((ob >> 9) & 1) << 5)); }
__host__ __device__ __forceinline__ void stage_rc(int b, int& R, int& C) { const int st = b / 1024, sb = b % 1024, swz = sb ^ (((sb >> 9) & 1) << 5); R = (st >> 1) * 16 + swz / 64; C = (st & 1) * 32 + (swz % 64) / 2; }
__host__ __device__ __forceinline__ int perm32(int rho) { const int n = rho >> 4, i = rho & 15; return 8 * (i >> 2) + 4 * n + (i & 3); }

struct Unit { int pm, pn; };
struct Gemm { const bf16_t* A; const bf16_t* Bt; int M, N, K; };

struct StaticOrder {
    int nM, nN, nwg, G, c;
    __host__ __device__ void init(int M, int N, int G_, int c_) { nM = M / BM; nN = N / BM; nwg = nM * nN; G = G_; c = c_; }
    __host__ __device__ bool next(int i, Unit& u) const {
        const long L = (long)i * G + c; if (L >= nwg) return false;
        int wgid = (int)L; { const int q = nwg / NXCD, r = nwg % NXCD, xcd = wgid % NXCD, off = wgid / NXCD; wgid = (xcd < r ? xcd * (q + 1) : r * (q + 1) + (xcd - r) * q) + off; }
        const int nig = WGM * nN, gid = wgid / nig, fm = gid * WGM, gsz = (nM - fm) < WGM ? (nM - fm) : WGM;
        u.pm = fm + ((wgid % nig) % gsz); u.pn = (wgid % nig) / gsz; return true;
    }
    __device__ __forceinline__ void a_ready(const Unit&) const {}
    __device__ __forceinline__ void done(const Unit&) const {}
};

template <class Epi, class Sched, bool ALIGN_EPI = false, bool SP2 = false>
__device__ __forceinline__ void gemm_phase(PG8_LAS unsigned char* lds, const Gemm g, const Sched& S, const Epi& E) {
    const int tid = opaque_tid(), wid = __builtin_amdgcn_readfirstlane(tid >> 6), lane = tid & 63, wr = wid >> 2, wc = wid & 3, fr = lane & 15, fq = lane >> 4;
    const int K = g.K, nt = K / BK;
    unsigned voffA[2], voffB[2];
#pragma unroll
    for (int i = 0; i < 2; ++i) { int R, C; stage_rc(tid * 16 + i * 8192, R, C); const int Rb = Epi::PERM ? ((R & ~31) + perm32(R & 31)) : R;
        voffA[i] = (unsigned)(R * K + C) * 2u; voffB[i] = (unsigned)(Rb * K + C) * 2u; }
    const size_t kstep = (size_t)(BK * 2);
    const size_t hstep = (size_t)HALF * K * 2;
    const size_t tstep = 2 * hstep;
    const unsigned ldsw = (unsigned)wid * 1024u;
    const int aoff = lds_byte(wr * 64 + fr, fq * 8), boff = lds_byte(wc * 32 + fr, fq * 8);
#define PG8_SA(b, h) (((b) * 2 + (h)) * HTB)
#define PG8_SB(b, h) ((4 + (b) * 2 + (h)) * HTB)
#define PG8_STAGE(bufoff, gbase, voff) do { _Pragma("unroll") for (int _i = 0; _i < 2; ++_i) \
        __builtin_amdgcn_global_load_lds((const unsigned*)((const char*)(gbase) + (voff)[_i]), (PG8_LAS unsigned*)(lds + (bufoff) + ldsw + _i * 8192), 16, 0, 0); } while (0)
#define PG8_LDA(dst, b, h) do { _Pragma("unroll") for (int m = 0; m < 4; ++m) _Pragma("unroll") for (int k = 0; k < 2; ++k) dst[m][k] = *(const PG8_LAS bf16x8*)(lds + PG8_SA(b, h) + aoff + m * 2048 + k * 1024); } while (0)
#define PG8_LDB(dst, b, h) do { _Pragma("unroll") for (int n = 0; n < 2; ++n) _Pragma("unroll") for (int k = 0; k < 2; ++k) dst[n][k] = *(const PG8_LAS bf16x8*)(lds + PG8_SB(b, h) + boff + n * 2048 + k * 1024); } while (0)
#define PG8_MMA(ai, bj, At, Bt) do { __builtin_amdgcn_s_setprio(1); _Pragma("unroll") for (int m = 0; m < 4; ++m) _Pragma("unroll") for (int n = 0; n < 2; ++n) _Pragma("unroll") for (int k = 0; k < 2; ++k) \
        acc[ai][bj][m][n] = __builtin_amdgcn_mfma_f32_16x16x32_bf16(Bt[n][k], At[m][k], acc[ai][bj][m][n], 0, 0, 0); __builtin_amdgcn_s_setprio(0); } while (0)
#define PG8_WAIT_V(n) asm volatile("s_waitcnt vmcnt(" #n ")" ::: "memory")
#define PG8_WAIT_L(n) asm volatile("s_waitcnt lgkmcnt(" #n ")" ::: "memory")
#define PG8_BAR __builtin_amdgcn_s_barrier()
#define PG8_SCHED __builtin_amdgcn_sched_barrier(0)
    Unit cur, nxt; int ui = 0;
    if (!S.next(0, cur)) return;
    f32x4 acc[2][2][4][2];
#pragma unroll
    for (int a = 0; a < 2; ++a)
#pragma unroll
        for (int b = 0; b < 2; ++b)
#pragma unroll
            for (int m = 0; m < 4; ++m)
#pragma unroll
                for (int n = 0; n < 2; ++n) acc[a][b][m][n] = (f32x4){0.f, 0.f, 0.f, 0.f};
    bf16x8 At[4][2], B0[2][2], B1[2][2];
    const char* cA = (const char*)g.A + (size_t)cur.pm * tstep; const char* cB = (const char*)g.Bt + (size_t)cur.pn * tstep;
    S.a_ready(cur);
    if constexpr (SP2) {
        PG8_STAGE(PG8_SB(0, 0), cB, voffB); PG8_STAGE(PG8_SB(0, 1), cB + hstep, voffB); PG8_STAGE(PG8_SA(0, 0), cA, voffA); PG8_STAGE(PG8_SA(0, 1), cA + hstep, voffA);
        if (wr == 1) PG8_BAR;
        PG8_WAIT_V(2); PG8_BAR;
        PG8_STAGE(PG8_SB(1, 0), cB + kstep, voffB); PG8_STAGE(PG8_SA(1, 0), cA + kstep, voffA); PG8_STAGE(PG8_SB(1, 1), cB + hstep + kstep, voffB);
        PG8_WAIT_V(6); PG8_BAR;
    } else {
        PG8_STAGE(PG8_SB(0, 0), cB, voffB); PG8_STAGE(PG8_SA(0, 0), cA, voffA); PG8_STAGE(PG8_SB(0, 1), cB + hstep, voffB); PG8_STAGE(PG8_SA(0, 1), cA + hstep, voffA);
        if (wr == 1) PG8_BAR;
        PG8_WAIT_V(4); PG8_BAR;
        PG8_STAGE(PG8_SB(1, 0), cB + kstep, voffB); PG8_STAGE(PG8_SA(1, 0), cA + kstep, voffA); PG8_STAGE(PG8_SB(1, 1), cB + hstep + kstep, voffB);
        PG8_WAIT_V(6); PG8_BAR;
    }
    for (;;) {
        const bool has_next = S.next(ui + 1, nxt);
        const char* nA = has_next ? (const char*)g.A + (size_t)nxt.pm * tstep : cA; const char* nB = has_next ? (const char*)g.Bt + (size_t)nxt.pn * tstep : cB;
        for (int t = 0; t < nt; t += 2) {
            const bool last = (t == nt - 2);
            const char* a1 = cA + (size_t)(t + 1) * kstep;
            const char* a2 = last ? nA : cA + (size_t)(t + 2) * kstep; const char* b2 = last ? nB : cB + (size_t)(t + 2) * kstep;
            const char* a3 = a2 + kstep; const char* b3 = b2 + kstep;
            if (last && has_next) S.a_ready(nxt);
            if constexpr (SP2) {
            PG8_LDB(B0, 0, 0); PG8_LDB(B1, 0, 1); PG8_SCHED; PG8_LDA(At, 0, 0); PG8_STAGE(PG8_SA(1, 1), a1 + hstep, voffA);
            PG8_WAIT_V(8); PG8_WAIT_L(0); PG8_BAR; PG8_MMA(0, 0, At, B0); PG8_MMA(0, 1, At, B1); PG8_BAR; PG8_SCHED;
            PG8_LDA(At, 0, 1); PG8_STAGE(PG8_SB(0, 0), b2, voffB); PG8_STAGE(PG8_SB(0, 1), b2 + hstep, voffB); PG8_STAGE(PG8_SA(0, 0), a2, voffA);
            PG8_WAIT_V(8); PG8_WAIT_L(0); PG8_BAR; PG8_MMA(1, 0, At, B0); PG8_MMA(1, 1, At, B1); PG8_BAR; PG8_SCHED;
            PG8_LDB(B0, 1, 0); PG8_LDB(B1, 1, 1); PG8_SCHED; PG8_LDA(At, 1, 0); PG8_STAGE(PG8_SA(0, 1), a2 + hstep, voffA);
            PG8_WAIT_V(8); PG8_WAIT_L(0); PG8_BAR; PG8_MMA(0, 0, At, B0); PG8_MMA(0, 1, At, B1); PG8_BAR; PG8_SCHED;
            PG8_LDA(At, 1, 1); PG8_STAGE(PG8_SB(1, 0), b3, voffB); PG8_STAGE(PG8_SB(1, 1), b3 + hstep, voffB); PG8_STAGE(PG8_SA(1, 0), a3, voffA);
            PG8_WAIT_V(8); PG8_WAIT_L(0); PG8_BAR; PG8_MMA(1, 0, At, B0); PG8_MMA(1, 1, At, B1); PG8_BAR; PG8_SCHED;
            } else {
            PG8_LDB(B0, 0, 0); PG8_SCHED; PG8_LDA(At, 0, 0); PG8_STAGE(PG8_SA(1, 1), a1 + hstep, voffA);
            PG8_WAIT_L(8); PG8_BAR; PG8_WAIT_L(0); PG8_MMA(0, 0, At, B0); PG8_BAR; PG8_SCHED;
            PG8_LDB(B1, 0, 1); PG8_STAGE(PG8_SB(0, 0), b2, voffB);
            PG8_BAR; PG8_WAIT_L(0); PG8_MMA(0, 1, At, B1); PG8_BAR;
            PG8_LDA(At, 0, 1); PG8_STAGE(PG8_SA(0, 0), a2, voffA);
            PG8_BAR; PG8_WAIT_L(0); PG8_MMA(1, 0, At, B0); PG8_BAR; PG8_SCHED;
            PG8_STAGE(PG8_SB(0, 1), b2 + hstep, voffB);
            PG8_WAIT_V(6); PG8_BAR; PG8_MMA(1, 1, At, B1); PG8_BAR;
            PG8_LDB(B0, 1, 0); PG8_SCHED; PG8_LDA(At, 1, 0); PG8_STAGE(PG8_SA(0, 1), a2 + hstep, voffA);
            PG8_WAIT_L(8); PG8_BAR; PG8_WAIT_L(0); PG8_MMA(0, 0, At, B0); PG8_BAR; PG8_SCHED;
            PG8_LDB(B1, 1, 1); PG8_STAGE(PG8_SB(1, 0), b3, voffB);
            PG8_BAR; PG8_WAIT_L(0); PG8_MMA(0, 1, At, B1); PG8_BAR;
            PG8_LDA(At, 1, 1); PG8_STAGE(PG8_SA(1, 0), a3, voffA);
            PG8_BAR; PG8_WAIT_L(0); PG8_MMA(1, 0, At, B0); PG8_BAR; PG8_SCHED;
            PG8_STAGE(PG8_SB(1, 1), b3 + hstep, voffB);
            PG8_WAIT_V(6); PG8_BAR; PG8_MMA(1, 1, At, B1); PG8_BAR;
            }
        }
        if constexpr (ALIGN_EPI) { if (wr == 0) PG8_BAR; }
        if constexpr (!Epi::AFTER_DRAIN) { E(acc, cur, wr, wc, fr, fq); S.done(cur); }
        if (!has_next) break;
#pragma unroll
        for (int a = 0; a < 2; ++a)
#pragma unroll
            for (int b = 0; b < 2; ++b)
#pragma unroll
                for (int m = 0; m < 4; ++m)
#pragma unroll
                    for (int n = 0; n < 2; ++n) acc[a][b][m][n] = (f32x4){0.f, 0.f, 0.f, 0.f};
        cur = nxt; cA = nA; cB = nB; ++ui;
        if constexpr (ALIGN_EPI) { if (wr == 1) PG8_BAR; }
    }
    PG8_WAIT_V(0);
    if constexpr (!ALIGN_EPI) { if (wr == 0) PG8_BAR; }
    PG8_BAR;
    if constexpr (Epi::AFTER_DRAIN) { E.fused(acc, cur, wr, wc, fr, fq, lds, wid, lane); S.done(cur); }
#undef PG8_SA
#undef PG8_SB
#undef PG8_STAGE
#undef PG8_LDA
#undef PG8_LDB
#undef PG8_MMA
#undef PG8_WAIT_V
#undef PG8_WAIT_L
#undef PG8_BAR
#undef PG8_SCHED
}
}

struct EpiInProj {
  static constexpr bool PERM = false, AFTER_DRAIN = false;
  char* ws; const float* gq; const float* gk; const float* swl;
  __device__ __forceinline__ float row_rstd(int t) const {
    const f32x4* q = (const f32x4*)(ws + OFF_SSQX) + (size_t)t * 4; const f32x4 a = q[0], b = q[1], c = q[2], d = q[3];
    const float s = ((a[0] + a[1]) + (a[2] + a[3])) + ((b[0] + b[1]) + (b[2] + b[3])) + ((c[0] + c[1]) + (c[2] + c[3])) + ((d[0] + d[1]) + (d[2] + d[3]));
    return rsqrtf(s * (1.f / 1024.f) + EPS); }
  __device__ __forceinline__ void operator()(const f32x4 (&acc0)[2][2][4][2], const pg8::Unit& u, int wr, int wc, int fr, int fq) const {
    const int pn = u.pn, rb = u.pm * 256 + wr * 64 + fr;
    const float2* ROPE = (const float2*)(ws + OFF_ROPE);
    int bb0, s00; tok_info(u.pm * 256, bb0, s00);
    const float* sw = swl + (size_t)bb0 * NPAD + pn * 256 + wc * 32 + fq * 4;
    f32x4 swv[2][2];
#pragma unroll
    for (int bj = 0; bj < 2; ++bj)
#pragma unroll
      for (int n = 0; n < 2; ++n) swv[bj][n] = *(const f32x4*)(sw + bj * 128 + n * 16);
#define AV(bj, n) (acc0[ai][bj][m][n] * rs + swv[bj][n])
    if (pn == 0) {
      bf16_t* Q = (bf16_t*)(ws + OFF_QLAT); float* ssq = (float*)(ws + OFF_SSQQ);
#pragma unroll
      for (int ai = 0; ai < 2; ++ai)
#pragma unroll
        for (int m = 0; m < 4; ++m) { const int t = rb + ai * 128 + m * 16; const float rs = row_rstd(t); float ss = 0.f;
#pragma unroll
          for (int bj = 0; bj < 2; ++bj)
#pragma unroll
            for (int n = 0; n < 2; ++n) { const f32x4 v = AV(bj, n); ss += v[0] * v[0] + v[1] * v[1] + v[2] * v[2] + v[3] * v[3];
              st_bf4(Q + (size_t)t * 256 + bj * 128 + wc * 32 + n * 16 + fq * 4, v); }
          ss += __shfl_xor(ss, 16); ss += __shfl_xor(ss, 32);
          if (fq == 0) ssq[t * 4 + wc] = ss; }
    } else if (pn == 1) {
      bf16_t* KV = (bf16_t*)(ws + OFF_KVLAT); float* ssq = (float*)(ws + OFF_SSQKV); bf16_t* KR = (bf16_t*)(ws + OFF_KROPE);
#pragma unroll
      for (int ai = 0; ai < 2; ++ai)
#pragma unroll
        for (int m = 0; m < 4; ++m) { const int t = rb + ai * 128 + m * 16; const float rs = row_rstd(t); float ss = 0.f;
#pragma unroll
          for (int n = 0; n < 2; ++n) { const f32x4 v = AV(0, n); ss += v[0] * v[0] + v[1] * v[1] + v[2] * v[2] + v[3] * v[3];
            st_bf4(KV + (size_t)t * 128 + wc * 32 + n * 16 + fq * 4, v); }
          ss += __shfl_xor(ss, 16); ss += __shfl_xor(ss, 32);
          if (fq == 0) ssq[t * 4 + wc] = ss;
          if (wc == 0) { int bb, s; tok_info(t, bb, s);
            f32x4 x1 = AV(1, 0), x2 = AV(1, 1);
            float rs = x1[0] * x1[0] + x1[1] * x1[1] + x1[2] * x1[2] + x1[3] * x1[3] + x2[0] * x2[0] + x2[1] * x2[1] + x2[2] * x2[2] + x2[3] * x2[3];
            rs += __shfl_xor(rs, 16); rs += __shfl_xor(rs, 32);
            if (fq == 0) ((float*)(ws + OFF_KRSS))[t] = rs;
            rope4(x1, x2, ROPE + s * 16 + fq * 4);
            st_bf4(KR + (size_t)t * 32 + fq * 4, x1); st_bf4(KR + (size_t)t * 32 + 16 + fq * 4, x2); } }
    } else if (pn <= 4) {
      if (pn == 4 && wc >= 2) {
#pragma unroll
        for (int ai = 0; ai < 2; ++ai)
#pragma unroll
          for (int m = 0; m < 4; ++m) { const int t = rb + ai * 128 + m * 16; const float rs = row_rstd(t);
            bf16_t* dst = (bf16_t*)(ws + OFF_VB) + (size_t)hm_row<2>(t, wc - 2) * 64 + fq * 4;
#pragma unroll
            for (int bj = 0; bj < 2; ++bj)
#pragma unroll
              for (int n = 0; n < 2; ++n) st_bf4(dst + bj * 32 + n * 16, AV(bj, n)); }
      } else {
        const float* gv = pn < 4 ? gq : gk;
        f32x4 g[2][2];
#pragma unroll
        for (int bj = 0; bj < 2; ++bj)
#pragma unroll
          for (int n = 0; n < 2; ++n) g[bj][n] = *(const f32x4*)(gv + bj * 32 + n * 16 + fq * 4);
#pragma unroll
        for (int ai = 0; ai < 2; ++ai)
#pragma unroll
          for (int m = 0; m < 4; ++m) { const int t = rb + ai * 128 + m * 16; const float rs = row_rstd(t); int bb, s; tok_info(t, bb, s); float ss = 0.f;
#pragma unroll
            for (int bj = 0; bj < 2; ++bj)
#pragma unroll
              for (int n = 0; n < 2; ++n) { const f32x4 v = AV(bj, n); ss += v[0] * v[0] + v[1] * v[1] + v[2] * v[2] + v[3] * v[3]; }
            ss += __shfl_xor(ss, 16); ss += __shfl_xor(ss, 32);
            const float rstd = rsqrtf(ss * (1.f / 64.f) + EPS) * (pn < 4 ? C_GQA : 1.f);
            f32x4 y[2][2];
#pragma unroll
            for (int bj = 0; bj < 2; ++bj)
#pragma unroll
              for (int n = 0; n < 2; ++n) { const f32x4 v = AV(bj, n), gg = g[bj][n];
                y[bj][n][0] = v[0] * rstd * gg[0]; y[bj][n][1] = v[1] * rstd * gg[1]; y[bj][n][2] = v[2] * rstd * gg[2]; y[bj][n][3] = v[3] * rstd * gg[3]; }
            rope4(y[0][0], y[0][1], ROPE + (s >> 6) * 16 + fq * 4);
            rope4(y[1][0], y[1][1], ROPE + (s & 63) * 16 + fq * 4);
            bf16_t* dst = pn < 4 ? (bf16_t*)(ws + OFF_QB) + (size_t)t * 512 + ((pn - 2) * 4 + wc) * 64 + fq * 4
                                 : (bf16_t*)(ws + OFF_KB) + (size_t)hm_row<2>(t, wc) * 64 + fq * 4;
#pragma unroll
            for (int bj = 0; bj < 2; ++bj)
#pragma unroll
              for (int n = 0; n < 2; ++n) st_bf4(dst + bj * 32 + n * 16, y[bj][n]); }
      }
    } else {
      bf16_t* G = (bf16_t*)(ws + OFF_G);
#pragma unroll
      for (int ai = 0; ai < 2; ++ai)
#pragma unroll
        for (int m = 0; m < 4; ++m) { const int t = rb + ai * 128 + m * 16; const float rs = row_rstd(t);
#pragma unroll
          for (int bj = 0; bj < 2; ++bj)
#pragma unroll
            for (int n = 0; n < 2; ++n) { const f32x4 a = AV(bj, n); f32x4 v; v[0] = silu_f(a[0]); v[1] = silu_f(a[1]); v[2] = silu_f(a[2]); v[3] = silu_f(a[3]);
              st_bf4(G + (size_t)t * 1024 + (pn - 5) * 256 + bj * 128 + wc * 32 + n * 16 + fq * 4, v); } }
    }
  }
#undef AV
};
struct EpiOutProj {
  static constexpr bool PERM = false, AFTER_DRAIN = false;
  const float* xp; const float* xs; float* out; const float* modl; int first;
  const float* gnext; bf16_t* H; float* ssqx; int has_next;
  __device__ __forceinline__ void operator()(const f32x4 (&acc)[2][2][4][2], const pg8::Unit& u, int wr, int wc, int fr, int fq) const {
    const int rb = u.pm * 256 + wr * 64 + fr, cb = u.pn * 256 + wc * 32 + fq * 4;
    int bb, s0; tok_info(u.pm * 256, bb, s0);
    const float* gate = modl + (size_t)bb * 3072 + 2048;
    const float* scn = modl + (size_t)(6 + bb) * 3072 + 1024;
    f32x4 gv[2][2], gm[2][2];
#pragma unroll
    for (int bj = 0; bj < 2; ++bj)
#pragma unroll
      for (int n = 0; n < 2; ++n) { const int c = cb + bj * 128 + n * 16; gv[bj][n] = *(const f32x4*)(gate + c);
        if (has_next) { const f32x4 g = *(const f32x4*)(gnext + c), s = *(const f32x4*)(scn + c);
          gm[bj][n][0] = g[0] * (1.f + s[0]); gm[bj][n][1] = g[1] * (1.f + s[1]); gm[bj][n][2] = g[2] * (1.f + s[2]); gm[bj][n][3] = g[3] * (1.f + s[3]); } }
#define XPTR(t_) (first ? ((t_) < TOKP ? xp + (size_t)(t_) * DM : xs + (size_t)((t_) - TOKP) * DM) : out + (size_t)(t_) * DM)
    f32x4 xc[2][2], xn[2][2];
    { const float* x0 = XPTR(rb);
#pragma unroll
      for (int bj = 0; bj < 2; ++bj)
#pragma unroll
        for (int n = 0; n < 2; ++n) xc[bj][n] = *(const f32x4*)(x0 + cb + bj * 128 + n * 16); }
#pragma unroll
    for (int ai = 0; ai < 2; ++ai)
#pragma unroll
      for (int m = 0; m < 4; ++m) { const int t = rb + ai * 128 + m * 16; float ss = 0.f;
        if (ai * 4 + m < 7) { const int tn = rb + ((ai * 4 + m + 1) >> 2) * 128 + ((ai * 4 + m + 1) & 3) * 16; const float* x1 = XPTR(tn);
#pragma unroll
          for (int bj = 0; bj < 2; ++bj)
#pragma unroll
            for (int n = 0; n < 2; ++n) xn[bj][n] = *(const f32x4*)(x1 + cb + bj * 128 + n * 16); }
#pragma unroll
        for (int bj = 0; bj < 2; ++bj)
#pragma unroll
          for (int n = 0; n < 2; ++n) { const int c = cb + bj * 128 + n * 16; const f32x4 g = gv[bj][n], x = xc[bj][n], a = acc[ai][bj][m][n];
            f32x4 o; o[0] = x[0] + g[0] * a[0]; o[1] = x[1] + g[1] * a[1]; o[2] = x[2] + g[2] * a[2]; o[3] = x[3] + g[3] * a[3];
            *(f32x4*)(out + (size_t)t * DM + c) = o;
            if (has_next) { ss += o[0] * o[0] + o[1] * o[1] + o[2] * o[2] + o[3] * o[3];
              f32x4 h; h[0] = o[0] * gm[bj][n][0]; h[1] = o[1] * gm[bj][n][1]; h[2] = o[2] * gm[bj][n][2]; h[3] = o[3] * gm[bj][n][3];
              st_bf4(H + (size_t)t * DM + c, h); } }
        if (has_next) { ss += __shfl_xor(ss, 16); ss += __shfl_xor(ss, 32); if (fq == 0) ssqx[t * 16 + u.pn * 4 + wc] = ss; }
#pragma unroll
        for (int bj = 0; bj < 2; ++bj)
#pragma unroll
          for (int n = 0; n < 2; ++n) xc[bj][n] = xn[bj][n]; }
#undef XPTR
  }
};

struct EpiKvUp {
  static constexpr bool PERM = false, AFTER_DRAIN = false;
  char* ws; int l;
  __device__ __forceinline__ void operator()(const f32x4 (&acc)[2][2][4][2], const pg8::Unit& u, int wr, int wc, int fr, int fq) const {
    const int rb = u.pm * 256 + wr * 64 + fr;
    const float* SSQKV = (const float*)(ws + OFF_SSQKV); const float* KRSS = (const float*)(ws + OFF_KRSS);
    bf16_t* KVA = (bf16_t*)(ws + OFF_H);
    float kmx[2] = {0.f, 0.f};
#pragma unroll
    for (int ai = 0; ai < 2; ++ai)
#pragma unroll
      for (int m = 0; m < 4; ++m) { const int t = rb + ai * 128 + m * 16;
        const f32x4 sq = *(const f32x4*)(SSQKV + (size_t)t * 4);
        const float rstd = rsqrtf((sq[0] + sq[1] + sq[2] + sq[3]) * (1.f / 128.f) + EPS);
        const float kr = wc == 0 ? KRSS[t] : 0.f;
#pragma unroll
        for (int bj = 0; bj < 2; ++bj) { bf16_t* dst = KVA + (size_t)hm_row<8>(t, u.pn * 2 + bj) * 128 + wc * 32 + fq * 4; float ss = 0.f;
#pragma unroll
          for (int n = 0; n < 2; ++n) { const f32x4 v = acc[ai][bj][m][n] * rstd; ss += v[0] * v[0] + v[1] * v[1] + v[2] * v[2] + v[3] * v[3]; st_bf4(dst + n * 16, v); }
          ss += __shfl_xor(ss, 16); ss += __shfl_xor(ss, 32);
          kmx[bj] = fmaxf(kmx[bj], ss + kr); } }
    if (wc < 2) {
      int bb, s0; tok_info(u.pm * 256, bb, s0);
      unsigned* KM = wc == 0 ? (unsigned*)(ws + OFF_KMAX) : (unsigned*)(ws + OFF_BAR) + 3584;
#pragma unroll
      for (int bj = 0; bj < 2; ++bj) { float v = kmx[bj];
#pragma unroll
        for (int off = 1; off < 16; off <<= 1) v = fmaxf(v, __shfl_xor(v, off));
        if (fr == 0 && fq == 0) atomicMax(KM + (l * 6 + bb) * 8 + u.pn * 2 + bj, __float_as_uint(v)); }
    }
  }
};

#define KOFF(row, chunk) ((row) * 256 + ((((chunk)) ^ ((row) & 15)) << 4))
constexpr int A_SHM_V = 8192, A_SHM_K = 16384;
__device__ __forceinline__ int v_st(int k, int c) { const int kk = (k & ~0xC) | ((k & 4) << 1) | ((k & 8) >> 1); return ((kk >> 3) * 2 + (c >> 5)) * 512 + ((kk & 7) * 32 + (c & 31)) * 2; }
__device__ __forceinline__ int v_rd_base(int lane) { return ((lane & 3) << 3) | (((lane >> 2) & 3) << 6) | (((lane >> 4) & 1) << 5) | (((lane >> 5) & 1) << 8); }
constexpr int v_rd_off(int d0, int ks, int half) { return d0 * 512 + ks * 2048 + half * 1024; }
template <int OFF> __device__ __forceinline__ s16x4 tr_read(int vb) {
  s16x4 r; asm volatile("ds_read_b64_tr_b16 %0, %1 offset:%2" : "=&v"(r) : "v"(vb), "i"(OFF) : "memory"); return r;
}
template <int D0> __device__ __forceinline__ void pv_one(f32x16& od, int vb, bf16x8 pa0, bf16x8 pa1, bf16x8 pa2, bf16x8 pa3) {
  const s16x4 l0 = tr_read<v_rd_off(D0, 0, 0)>(vb), h0 = tr_read<v_rd_off(D0, 0, 1)>(vb), l1 = tr_read<v_rd_off(D0, 1, 0)>(vb), h1 = tr_read<v_rd_off(D0, 1, 1)>(vb);
  const s16x4 l2 = tr_read<v_rd_off(D0, 2, 0)>(vb), h2 = tr_read<v_rd_off(D0, 2, 1)>(vb), l3 = tr_read<v_rd_off(D0, 3, 0)>(vb), h3 = tr_read<v_rd_off(D0, 3, 1)>(vb);
  asm volatile("s_waitcnt lgkmcnt(0)" ::: "memory"); SBAR();
#define PK(L, H) (bf16x8){L[0], L[1], L[2], L[3], H[0], H[1], H[2], H[3]}
  od = __builtin_amdgcn_mfma_f32_32x32x16_bf16(pa0, PK(l0, h0), od, 0, 0, 0);
  od = __builtin_amdgcn_mfma_f32_32x32x16_bf16(pa1, PK(l1, h1), od, 0, 0, 0);
  od = __builtin_amdgcn_mfma_f32_32x32x16_bf16(pa2, PK(l2, h2), od, 0, 0, 0);
  od = __builtin_amdgcn_mfma_f32_32x32x16_bf16(pa3, PK(l3, h3), od, 0, 0, 0);
#undef PK
}
#define PK4(P, BASE, OUT) do { unsigned a0_ = cvtpk(P[BASE + 0], P[BASE + 1]), a1_ = cvtpk(P[BASE + 2], P[BASE + 3]);   \
    unsigned b0_ = cvtpk(P[BASE + 4], P[BASE + 5]), b1_ = cvtpk(P[BASE + 6], P[BASE + 7]);                              \
    auto r0_ = __builtin_amdgcn_permlane32_swap(a0_, b0_, false, false); auto r1_ = __builtin_amdgcn_permlane32_swap(a1_, b1_, false, false); \
    u32x4 w_ = {r0_[0], r1_[0], r0_[1], r1_[1]}; OUT = *reinterpret_cast<bf16x8*>(&w_); } while (0)

constexpr float ATT_THRL = 11.5f;
template <int DQK>
__device__ __forceinline__ void partialSM(f32x16& p0, f32x16& p1, float& m_reg, float& mn, float& alpha) {
  float pmax = p0[0];
#pragma unroll
  for (int r = 1; r < 16; ++r) pmax = fmaxf(pmax, p0[r]);
#pragma unroll
  for (int r = 0; r < 16; ++r) pmax = fmaxf(pmax, p1[r]);
  { auto rr = __builtin_amdgcn_permlane32_swap(__float_as_uint(pmax), __float_as_uint(pmax), false, false);
    pmax = fmaxf(__uint_as_float(rr[0]), __uint_as_float(rr[1])); }
  if (__builtin_expect(__all(pmax - m_reg <= ATT_THRL), 1)) { mn = m_reg; alpha = 1.f; }
  else { mn = fmaxf(m_reg, pmax); alpha = __builtin_amdgcn_exp2f(m_reg - mn); m_reg = mn; }
#pragma unroll
  for (int r = 0; r < 16; ++r) p0[r] = p0[r] - mn;
#pragma unroll
  for (int r = 0; r < 16; ++r) p1[r] = p1[r] - mn;
#pragma unroll
  for (int r = 0; r < 16; ++r) p0[r] = __builtin_amdgcn_exp2f(p0[r]);
}
__device__ __forceinline__ void finishSM(f32x16& p0, f32x16& p1, float alpha, float& l_reg, bf16x8& pa0, bf16x8& pa1, bf16x8& pa2, bf16x8& pa3) {
#pragma unroll
  for (int r = 0; r < 16; ++r) p1[r] = __builtin_amdgcn_exp2f(p1[r]);
  float ps = 0;
#pragma unroll
  for (int r = 0; r < 16; ++r) ps += p0[r];
#pragma unroll
  for (int r = 0; r < 16; ++r) ps += p1[r];
  { auto rr = __builtin_amdgcn_permlane32_swap(__float_as_uint(ps), __float_as_uint(ps), false, false);
    ps = __uint_as_float(rr[0]) + __uint_as_float(rr[1]); }
  l_reg = l_reg * alpha + ps;
  PK4(p0, 0, pa0); PK4(p0, 8, pa1); PK4(p1, 0, pa2); PK4(p1, 8, pa3);
}
template <int DQK>
__device__ __forceinline__ void qkt(f32x16& p0, f32x16& p1, const char* Ks, const bf16x8 (&qr)[DQK / 16], int r32, int hi) {
  p0 = f32x16{}; p1 = f32x16{};
#pragma unroll
  for (int d0 = 0; d0 < DQK / 16; ++d0) { const int ch = d0 * 2 + hi;
    const bf16x8 b0 = *reinterpret_cast<const bf16x8*>(Ks + KOFF(r32, ch));
    const bf16x8 b1 = *reinterpret_cast<const bf16x8*>(Ks + KOFF(32 + r32, ch));
    p0 = __builtin_amdgcn_mfma_f32_32x32x16_bf16(b0, qr[d0], p0, 0, 0, 0);
    p1 = __builtin_amdgcn_mfma_f32_32x32x16_bf16(b1, qr[d0], p1, 0, 0, 0); }
}

template <int DQK>
__device__ __forceinline__ void attn_body(const bf16x8 (&qr)[DQK / 16], const bf16_t* __restrict__ Kg, int kld, const bf16_t* __restrict__ Krg,
                                          const bf16_t* __restrict__ Vg, int vld, int seq, bf16_t* __restrict__ Gout, char* lds, bool live) {
  const int tid = opaque_tid(), wid = uni(tid >> 6), lane = tid & 63, r32 = lane & 31, hi = lane >> 5;
  char* V_lds = lds; char* K_lds = lds + 2 * A_SHM_V;
  float* ws = (float*)(lds + 2 * A_SHM_V + 2 * A_SHM_K) + wid * 64; float* li_l = ws; float* al_l = ws + 32;
  float m_reg = -1e30f, l_reg = 0; f32x16 o[2] = {};
  const int srow = tid >> 3, sch = tid & 7, rrow = (tid & 255) >> 2, rch = tid & 3;
  const int vst = v_st(srow, sch * 8), kst = KOFF(srow, sch), rst = KOFF(rrow, 8 + rch);
  const int vb0 = (int)(uintptr_t)V_lds + v_rd_base(lane);
  const bf16_t* Kp = Kg + (size_t)srow * kld + sch * 8;
  const bf16_t* Vp = Vg + (size_t)srow * vld + sch * 8;
  const bf16_t* Rp = (DQK == 96) ? Krg + (size_t)rrow * 32 + rch * 8 : nullptr;
  u32x4 k_s0, v_s0, r_s0;
#define SLOAD0(k0) do { k_s0 = *(const u32x4*)(Kp + (size_t)(k0) * kld); v_s0 = *(const u32x4*)(Vp + (size_t)(k0) * vld); if (DQK == 96) r_s0 = *(const u32x4*)(Rp + (size_t)(k0) * 32); } while (0)
#define SWRITE0(b) do { *(u32x4*)(V_lds + (b) * A_SHM_V + vst) = v_s0; *(u32x4*)(K_lds + (b) * A_SHM_K + kst) = k_s0; if (DQK == 96) *(u32x4*)(K_lds + (b) * A_SHM_K + rst) = r_s0; } while (0)
#define RESC(a) do { if (__any((a) < 1.f)) { if (hi == 0) al_l[r32] = (a); asm volatile("s_waitcnt lgkmcnt(0)" ::: "memory"); \
    _Pragma("unroll") for (int d = 0; d < 2; ++d) _Pragma("unroll") for (int r = 0; r < 16; ++r) o[d][r] *= al_l[crow(r, hi)]; } } while (0)
#define PVALL(vb) do { pv_one<0>(o[0], (vb), pa0, pa1, pa2, pa3); pv_one<1>(o[1], (vb), pa0, pa1, pa2, pa3); } while (0)
  f32x16 pA0, pA1, pB0, pB1; float mnA, mnB, alA, alB; bf16x8 pa0, pa1, pa2, pa3; const int NT = seq / 64;
  SLOAD0(0); SWRITE0(0); __syncthreads();
  qkt<DQK>(pA0, pA1, K_lds, qr, r32, hi); partialSM<DQK>(pA0, pA1, m_reg, mnA, alA);
  SLOAD0(64); SWRITE0(1); __syncthreads();
  for (int j = 1; j + 1 < NT; j += 2) {
    SBAR(); qkt<DQK>(pB0, pB1, K_lds + A_SHM_K, qr, r32, hi);
    finishSM(pA0, pA1, alA, l_reg, pa0, pa1, pa2, pa3); SBAR();
    SLOAD0((j + 1) * 64); SBAR();
    PVALL(vb0); partialSM<DQK>(pB0, pB1, m_reg, mnB, alB);
    __syncthreads(); SWRITE0(0);
    RESC(alB); __syncthreads();
    SBAR(); qkt<DQK>(pA0, pA1, K_lds, qr, r32, hi);
    finishSM(pB0, pB1, alB, l_reg, pa0, pa1, pa2, pa3); SBAR();
    SLOAD0((j + 2) * 64); SBAR();
    PVALL(vb0 + A_SHM_V); partialSM<DQK>(pA0, pA1, m_reg, mnA, alA);
    __syncthreads(); SWRITE0(1);
    RESC(alA); __syncthreads();
  }
  SBAR(); qkt<DQK>(pB0, pB1, K_lds + A_SHM_K, qr, r32, hi);
  finishSM(pA0, pA1, alA, l_reg, pa0, pa1, pa2, pa3); SBAR();
  PVALL(vb0); partialSM<DQK>(pB0, pB1, m_reg, mnB, alB);
  __syncthreads(); RESC(alB);
  finishSM(pB0, pB1, alB, l_reg, pa0, pa1, pa2, pa3); SBAR();
  PVALL(vb0 + A_SHM_V);
  if (hi == 0) li_l[r32] = l_reg; asm volatile("s_waitcnt lgkmcnt(0)" ::: "memory");
  float rli[16];
#pragma unroll
  for (int r = 0; r < 16; ++r) rli[r] = __builtin_amdgcn_rcpf(li_l[crow(r, hi)]);
  bf16_t* Gw = Gout + (size_t)(wid * 32) * 1024 + r32;
  if (live) {
#pragma unroll
  for (int r = 0; r < 16; ++r) { const int orow = crow(r, hi);
#pragma unroll
    for (int d0 = 0; d0 < 2; ++d0) { bf16_t* gp = Gw + (size_t)orow * 1024 + d0 * 32; const float g = bf2f(*gp); *gp = f2bf(o[d0][r] * rli[r] * g); } }
  }
  __syncthreads();
#undef SLOAD0
#undef SWRITE0
#undef RESC
#undef PVALL
}


#define PK4S(P, BASE, OUT) do { unsigned a0_ = cvtpk_s(P[BASE + 0], P[BASE + 1]), a1_ = cvtpk_s(P[BASE + 2], P[BASE + 3]);   \
    unsigned b0_ = cvtpk_s(P[BASE + 4], P[BASE + 5]), b1_ = cvtpk_s(P[BASE + 6], P[BASE + 7]);                              \
    auto r0_ = __builtin_amdgcn_permlane32_swap(a0_, b0_, false, false); auto r1_ = __builtin_amdgcn_permlane32_swap(a1_, b1_, false, false); \
    u32x4 w_ = {r0_[0], r1_[0], r0_[1], r1_[1]}; OUT = *reinterpret_cast<bf16x8*>(&w_); } while (0)
constexpr int F_KN0 = 3 * 8192, F_KR0 = F_KN0 + 3 * 8192, F_RED = F_KR0 + 3 * 4096;
template <int DQK, class QF>
__device__ __forceinline__ bool attn_body_fast(QF qf, const bf16_t* __restrict__ Kg, int kld, const bf16_t* __restrict__ Krg,
                                               const bf16_t* __restrict__ Vg, int vld, int seq, bf16_t* __restrict__ Gout, char* lds, bool pre, bool pf) {
  constexpr long NDK = DQK == 96 ? 65536L * 128 : 16384L * 64;
  constexpr long NDR = 8192L * 32;
  const int tid = opaque_tid(), wid = uni(tid >> 6), lane = tid & 63, r32 = lane & 31, hi = lane >> 5;
  LAS unsigned char* L = (LAS unsigned char*)lds;
  f32x16 o0 = {}, o1 = {}; float l0 = 0.f, l1 = 0.f;
  const int vb0 = (int)(uintptr_t)lds + v_rd_base(lane);
  int kn_a[4], kr_a[2];
#pragma unroll
  for (int d0 = 0; d0 < 4; ++d0) kn_a[d0] = F_KN0 + r32 * 128 + (((d0 * 2 + hi) ^ ((r32 >> 1) & 7)) << 4);
#pragma unroll
  for (int d0 = 0; d0 < 2; ++d0) kr_a[d0] = F_KR0 + r32 * 64 + (((d0 * 2 + hi) ^ ((r32 >> 2) & 3)) << 4);
  unsigned voffV, voffK, voffR = 0;
  { const int b = wid * 1024 + lane * 16;
    { const int sub = b >> 9, k = (sub >> 1) * 8 + ((b & 511) >> 6), c = (sub & 1) * 32 + ((b & 63) >> 1); voffV = (unsigned)(k * vld + c) * 2u; }
    { const int row = b >> 7, c = ((b & 127) >> 4) ^ ((row >> 1) & 7); voffK = (unsigned)(row * kld + c * 8) * 2u; }
    if (DQK == 96) { const int row = (b & 4095) >> 6, c = ((b & 63) >> 4) ^ ((row >> 2) & 3); voffR = (unsigned)(row * 32 + c * 8) * 2u; } }
  const char* bV = (const char*)Vg; const char* bK = (const char*)Kg; const char* bR = (const char*)Krg;
  const int stV = 64 * vld * 2, stK = 64 * kld * 2;
#define DMA(slot) do { \
    __builtin_amdgcn_global_load_lds((const unsigned*)(bV + voffV), (LAS unsigned*)(L + (slot) * 8192 + wid * 1024), 16, 0, 0); bV += stV; \
    __builtin_amdgcn_global_load_lds((const unsigned*)(bK + voffK), (LAS unsigned*)(L + F_KN0 + (slot) * 8192 + wid * 1024), 16, 0, 0); bK += stK; \
    if (DQK == 96) { if (wid < 4) __builtin_amdgcn_global_load_lds((const unsigned*)(bR + voffR), (LAS unsigned*)(L + F_KR0 + (slot) * 4096 + wid * 1024), 16, 0, 0); bR += 64 * 32 * 2; } } while (0)
#define LANDED() do { asm volatile("s_waitcnt vmcnt(0)" ::: "memory"); __syncthreads(); } while (0)
#define QK(N0, N1, slot) do { N0 = f32x16{}; N1 = f32x16{}; bf16x8 kf0_[DQK / 16], kf1_[DQK / 16]; \
    _Pragma("unroll") for (int d0 = 0; d0 < 4; ++d0) { kf0_[d0] = *(const LAS bf16x8*)(L + kn_a[d0] + (slot) * 8192); kf1_[d0] = *(const LAS bf16x8*)(L + kn_a[d0] + (slot) * 8192 + 4096); } \
    if (DQK == 96) { _Pragma("unroll") for (int d0 = 0; d0 < 2; ++d0) { kf0_[DQK / 16 - 2 + d0] = *(const LAS bf16x8*)(L + kr_a[d0] + (slot) * 4096); kf1_[DQK / 16 - 2 + d0] = *(const LAS bf16x8*)(L + kr_a[d0] + (slot) * 4096 + 2048); } } \
    SBAR();   \
    _Pragma("unroll") for (int d0 = 0; d0 < DQK / 16; ++d0) { \
      N0 = __builtin_amdgcn_mfma_f32_32x32x16_bf16(kf0_[d0], qr[d0], N0, 0, 0, 0); N1 = __builtin_amdgcn_mfma_f32_32x32x16_bf16(kf1_[d0], qr[d0], N1, 0, 0, 0); } } while (0)
#define PKP(P, B) (bf16x8)__builtin_bit_cast(bf16x8, (u32x4){cvtpk_s(P[B + 0], P[B + 1]), cvtpk_s(P[B + 2], P[B + 3]), cvtpk_s(P[B + 4], P[B + 5]), cvtpk_s(P[B + 6], P[B + 7])})
#define FIN(P0, P1) do { _Pragma("unroll") for (int r = 0; r < 16; ++r) { P1[r] = __builtin_amdgcn_exp2f(P1[r]); if (r & 1) l1 += P1[r]; else l0 += P1[r]; } \
    pa0 = PKP(P0, 0); pa1 = PKP(P0, 8); pa2 = PKP(P1, 0); pa3 = PKP(P1, 8); } while (0)
#define PK(L_, H_) (bf16x8){L_[0], L_[1], L_[2], L_[3], H_[0], H_[1], H_[2], H_[3]}
#define PVX(slot, N0, DOEXP) do { const int vb = vb0; \
    s16x4 a0 = tr_read<v_rd_off(0, 0, 0) + (slot) * 8192>(vb), a1 = tr_read<v_rd_off(0, 0, 1) + (slot) * 8192>(vb), a2 = tr_read<v_rd_off(0, 1, 0) + (slot) * 8192>(vb), a3 = tr_read<v_rd_off(0, 1, 1) + (slot) * 8192>(vb); \
    s16x4 a4 = tr_read<v_rd_off(0, 2, 0) + (slot) * 8192>(vb), a5 = tr_read<v_rd_off(0, 2, 1) + (slot) * 8192>(vb), a6 = tr_read<v_rd_off(0, 3, 0) + (slot) * 8192>(vb), a7 = tr_read<v_rd_off(0, 3, 1) + (slot) * 8192>(vb); \
    s16x4 b0 = tr_read<v_rd_off(1, 0, 0) + (slot) * 8192>(vb), b1 = tr_read<v_rd_off(1, 0, 1) + (slot) * 8192>(vb), b2 = tr_read<v_rd_off(1, 1, 0) + (slot) * 8192>(vb), b3 = tr_read<v_rd_off(1, 1, 1) + (slot) * 8192>(vb); \
    s16x4 b4 = tr_read<v_rd_off(1, 2, 0) + (slot) * 8192>(vb), b5 = tr_read<v_rd_off(1, 2, 1) + (slot) * 8192>(vb), b6 = tr_read<v_rd_off(1, 3, 0) + (slot) * 8192>(vb), b7 = tr_read<v_rd_off(1, 3, 1) + (slot) * 8192>(vb); \
    if (DOEXP) { _Pragma("unroll") for (int r = 0; r < 16; ++r) { N0[r] = __builtin_amdgcn_exp2f(N0[r]); if (r & 1) l1 += N0[r]; else l0 += N0[r]; } } \
    asm volatile("s_waitcnt lgkmcnt(0)" : "+v"(a0), "+v"(a1), "+v"(a2), "+v"(a3), "+v"(a4), "+v"(a5), "+v"(a6), "+v"(a7), \
                 "+v"(b0), "+v"(b1), "+v"(b2), "+v"(b3), "+v"(b4), "+v"(b5), "+v"(b6), "+v"(b7) :: "memory");   \
    o0 = __builtin_amdgcn_mfma_f32_32x32x16_bf16(pa0, PK(a0, a1), o0, 0, 0, 0); o1 = __builtin_amdgcn_mfma_f32_32x32x16_bf16(pa0, PK(b0, b1), o1, 0, 0, 0); \
    o0 = __builtin_amdgcn_mfma_f32_32x32x16_bf16(pa1, PK(a2, a3), o0, 0, 0, 0); o1 = __builtin_amdgcn_mfma_f32_32x32x16_bf16(pa1, PK(b2, b3), o1, 0, 0, 0); \
    o0 = __builtin_amdgcn_mfma_f32_32x32x16_bf16(pa2, PK(a4, a5), o0, 0, 0, 0); o1 = __builtin_amdgcn_mfma_f32_32x32x16_bf16(pa2, PK(b4, b5), o1, 0, 0, 0); \
    o0 = __builtin_amdgcn_mfma_f32_32x32x16_bf16(pa3, PK(a6, a7), o0, 0, 0, 0); o1 = __builtin_amdgcn_mfma_f32_32x32x16_bf16(pa3, PK(b6, b7), o1, 0, 0, 0); } while (0)
#define PAIR(SP, SC, SN) do { \
    SBAR(); DMA(SN); SBAR(); QK(sB0, sB1, SC); FIN(sA0, sA1); SBAR(); PVX(SP, sB0, 1); SBAR(); LANDED(); \
    SBAR(); DMA(SP); SBAR(); QK(sA0, sA1, SN); FIN(sB0, sB1); SBAR(); PVX(SC, sA0, 1); SBAR(); LANDED(); } while (0)
  f32x16 sA0, sA1, sB0, sB1; bf16x8 pa0, pa1, pa2, pa3; const int NT = seq / 64;
  if (!pre) { DMA(0); DMA(1); } else { bV += 2 * stV; bK += 2 * stK; bR += 2 * 64 * 32 * 2; }
  bf16x8 qr[DQK / 16];
  const float bound = qf(qr);
  LANDED();
  if (!(bound < 60.f)) {
    attn_body<DQK>(qr, Kg, kld, Krg, Vg, vld, seq, Gout, lds, true);
    return false;
  }
  QK(sA0, sA1, 0);
#pragma unroll
  for (int r = 0; r < 16; ++r) { sA0[r] = __builtin_amdgcn_exp2f(sA0[r]); l0 += sA0[r]; }
  int j = 1, ph = 0;
  for (;;) {
    if (j + 1 >= NT) break;
    PAIR(0, 1, 2); j += 2; ph = 1;
    if (j + 1 >= NT) break;
    PAIR(2, 0, 1); j += 2; ph = 2;
    if (j + 1 >= NT) break;
    PAIR(1, 2, 0); j += 2; ph = 0;
  }
#define TAIL(SP, SC) do { SBAR(); QK(sB0, sB1, SC); FIN(sA0, sA1); SBAR(); PVX(SP, sB0, 1); SBAR(); FIN(sB0, sB1); SBAR(); GLOADS(); SBAR(); PVX(SC, sB0, 0); } while (0)
  bf16_t* Gw = Gout + (size_t)(wid * 32) * 1024 + r32;
  unsigned short gq0[16], gq1[16];
#define GLOADS() do { _Pragma("unroll") for (int r = 0; r < 16; ++r) { const bf16_t* gp_ = Gw + (size_t)crow(r, hi) * 1024; gq0[r] = gp_[0]; gq1[r] = gp_[32]; } } while (0)
  if (ph == 0) TAIL(0, 1); else if (ph == 1) TAIL(2, 0); else TAIL(1, 2);
  if (pf) {
    asm volatile("s_waitcnt lgkmcnt(0)" ::: "memory"); __builtin_amdgcn_s_barrier();
    bV += NDK * 2 - (long)NT * stV; bK += NDK * 2 - (long)NT * stK; if (DQK == 96) bR += NDR * 2 - (long)NT * (64 * 32 * 2);
    DMA(0); DMA(1);
  }
  float l_reg = l0 + l1;
  { auto rr = __builtin_amdgcn_permlane32_swap(__float_as_uint(l_reg), __float_as_uint(l_reg), false, false);
    l_reg = __uint_as_float(rr[0]) + __uint_as_float(rr[1]); }
  float* li_l = (float*)(lds + F_RED + 64) + wid * 32;
  if (hi == 0) li_l[r32] = l_reg; asm volatile("s_waitcnt lgkmcnt(0)" ::: "memory");
#pragma unroll
  for (int r = 0; r < 16; ++r) { const int orow = crow(r, hi); const float rl = __builtin_amdgcn_rcpf(li_l[orow]);
    bf16_t* gp = Gw + (size_t)orow * 1024; const float g0 = bf2f(gq0[r]), g1 = bf2f(gq1[r]);
    gp[0] = f2bf(o0[r] * rl * g0); gp[32] = f2bf(o1[r] * rl * g1); }
  if (pf) { asm volatile("s_waitcnt lgkmcnt(0)" ::: "memory"); __builtin_amdgcn_s_barrier(); }
  else __syncthreads();
  return pf;
#undef DMA
#undef LANDED
#undef QK
#undef PKP
#undef FIN
#undef PK
#undef PVX
#undef PAIR
#undef TAIL
#undef GLOADS
}

__device__ void attn_phase(const Params& p, int l, char* lds, bool live = true) {
  const int tid = opaque_tid(), wid = uni(tid >> 6), lane = tid & 63, r32 = lane & 31, hi = lane >> 5;
  bf16_t* G = (bf16_t*)(p.ws + OFF_G);
  const bf16_t* KVA = (const bf16_t*)(p.ws + OFF_H);
  const bf16_t* KR = (const bf16_t*)(p.ws + OFF_KROPE);
  const bf16_t* QB = (const bf16_t*)(p.ws + OFF_QB);
  const bf16_t* KB = (const bf16_t*)(p.ws + OFF_KB);
  const bf16_t* VB = (const bf16_t*)(p.ws + OFF_VB);
  const bf16_t* QLAT = (const bf16_t*)(p.ws + OFF_QLAT);
  const float* SSQQ = (const float*)(p.ws + OFF_SSQQ);
  const float2* ROPE = (const float2*)(p.ws + OFF_ROPE);
  const bf16_t* WTUQ = (const bf16_t*)(p.ws + OFF_WTUQ) + (size_t)l * 768 * 256;
  int staged_h = -1; bool pre = false;
  for (int it = blockIdx.x; it < 2048; it += gridDim.x) {
    const int step = it >> 8, w = it & 255, cls = step >> 1, sub = step & 1, x = w & 7, j = w >> 3;
    const bool sample = cls < 2, mla = (cls & 1) == 0;
    int bh, qblk;
    if (sample) { bh = sub * 8 + x; qblk = j; } else { bh = sub * 16 + x * 2 + (j >> 4); qblk = j & 15; }
    const int b = bh >> 3, h = bh & 7;
    const int S = sample ? 8192 : 4096;
    const int tseq = sample ? TOKP + b * 8192 : b * 4096;
    const int t0 = tseq + qblk * 256;
    const int trow = t0 + wid * 32 + r32;
    if (mla) {
      const int kmi = (l * 6 + (sample ? 4 + b : b)) * 8 + h;
      const float kmx = __uint_as_float(((const unsigned*)(p.ws + OFF_KMAX))[kmi]) + __uint_as_float(((const unsigned*)(p.ws + OFF_BAR))[3584 + kmi]);
      const int spos = qblk * 256 + wid * 32 + r32;
      const bool need_w = (h != staged_h); staged_h = h;
      auto qf = [=](bf16x8 (&qr)[6]) -> float {
        LAS unsigned char* Lw = (LAS unsigned char*)lds + 65536;
        const f32x4 sq = *(const f32x4*)(SSQQ + (size_t)trow * 4);
        if (need_w) { const char* wbase = (const char*)(WTUQ + (size_t)h * 96 * 256);
          int ln = lane; asm volatile("" : "+v"(ln));
#pragma unroll
          for (int i = 0; i < 6; ++i) { const int pc = wid * 6 + i, row = pc * 2 + (ln >> 5), c = (ln & 31) ^ (row & 31);
            __builtin_amdgcn_global_load_lds((const unsigned*)(wbase + (unsigned)((row * 256 + c * 8) * 2)), (LAS unsigned*)(Lw + pc * 1024), 16, 0, 0); } }
        const bf16_t* qlp = QLAT + (size_t)trow * 256 + hi * 8;
        if (need_w) { asm volatile("s_waitcnt vmcnt(0)" ::: "memory"); __syncthreads(); }
        f32x16 c0 = {}, c1 = {}, c2 = {};
#pragma unroll 8
        for (int ks = 0; ks < 16; ++ks) { const int ao = r32 * 512 + (((ks * 2 + hi) ^ r32) << 4);
          const bf16x8 bk = *(const bf16x8*)(qlp + ks * 16);
          const bf16x8 a0 = *(const LAS bf16x8*)(Lw + ao), a1 = *(const LAS bf16x8*)(Lw + ao + 16384), a2 = *(const LAS bf16x8*)(Lw + ao + 32768);
          c0 = __builtin_amdgcn_mfma_f32_32x32x16_bf16(a0, bk, c0, 0, 0, 0);
          c1 = __builtin_amdgcn_mfma_f32_32x32x16_bf16(a1, bk, c1, 0, 0, 0);
          c2 = __builtin_amdgcn_mfma_f32_32x32x16_bf16(a2, bk, c2, 0, 0, 0);
        }
        const float rstd = rsqrtf((sq[0] + sq[1] + sq[2] + sq[3]) * (1.f / 256.f) + EPS) * C_MLA;
        float qn = 0.f;
#pragma unroll
        for (int r = 0; r < 16; ++r) { c0[r] *= rstd; c1[r] *= rstd; c2[r] *= rstd; qn += c0[r] * c0[r] + c1[r] * c1[r] + c2[r] * c2[r]; }
        const float2* rp = ROPE + (size_t)spos * 16;
#pragma unroll
        for (int r = 0; r < 8; ++r) { const float2 cs = rp[crow(r, hi)]; const float a = c2[r], bq2 = c2[r + 8];
          c2[r] = a * cs.x - bq2 * cs.y; c2[r + 8] = a * cs.y + bq2 * cs.x; }
        PK4(c0, 0, qr[0]); PK4(c0, 8, qr[1]); PK4(c1, 0, qr[2]); PK4(c1, 8, qr[3]); PK4(c2, 0, qr[4]); PK4(c2, 8, qr[5]);
        qn += __shfl_xor(qn, 32);
#pragma unroll
        for (int off = 1; off < 32; off <<= 1) qn = fmaxf(qn, __shfl_xor(qn, off));
        float* red = (float*)(lds + F_RED);
        if (lane == 0) red[wid] = qn;
        __syncthreads();
        float qmx = red[0];
#pragma unroll
        for (int i = 1; i < 8; ++i) qmx = fmaxf(qmx, red[i]);
        return sqrtf(qmx * kmx) * 1.05f;
      };
      const size_t kvrow0 = (size_t)hm_row<8>(tseq, h);
      pre = attn_body_fast<96>(qf, KVA + kvrow0 * 128, 128, KR + (size_t)tseq * 32, KVA + kvrow0 * 128 + 64, 128, S, G + (size_t)t0 * 1024 + h * 64, lds, pre, gridDim.x == 256 && sub == 0);
    } else {
      const size_t kvrow0 = (size_t)hm_row<2>(tseq, h >> 2);
      const float* gqn = p.g_qn + l * 64; const float* gkn = p.g_kn + l * 64;
      auto qf = [=](bf16x8 (&qr)[4]) -> float {
        const bf16_t* qp = QB + (size_t)trow * 512 + h * 64 + hi * 8;
#pragma unroll
        for (int d0 = 0; d0 < 4; ++d0) qr[d0] = *(const bf16x8*)(qp + d0 * 16);
        float gq = fabsf(gqn[lane]), gk = fabsf(gkn[lane]);
#pragma unroll
        for (int off = 1; off < 64; off <<= 1) { gq = fmaxf(gq, __shfl_xor(gq, off)); gk = fmaxf(gk, __shfl_xor(gk, off)); }
        return 64.f * C_GQA * gq * gk * 1.05f;
      };
      pre = attn_body_fast<64>(qf, KB + kvrow0 * 64, 64, nullptr, VB + kvrow0 * 64, 64, S, G + (size_t)t0 * 1024 + 512 + h * 64, lds, pre, gridDim.x == 256 && sub == 0);
    }
  }
}

#define XB_TMO      128
#define XB_XCNT(j)  (256  + 64 * (j))
#define XB_XSUB(j)  (1280 + 64 * (j))
#define XB_XGEN(j)  (2304 + 64 * (j))
#define XB_TOP      3328
#define XB_TOPGEN   3392
#define XCD_BAR_WORDS 3456
#define XB_SPIN_CAP (1u << 18)

__device__ __forceinline__ unsigned xb_ld(unsigned* p)              { return __hip_atomic_load(p, __ATOMIC_RELAXED, __HIP_MEMORY_SCOPE_AGENT); }
__device__ __forceinline__ unsigned xb_add(unsigned* p, unsigned v) { return __hip_atomic_fetch_add(p, v, __ATOMIC_RELAXED, __HIP_MEMORY_SCOPE_AGENT); }
__device__ __forceinline__ unsigned xb_xcc_id() { return (unsigned)__builtin_amdgcn_s_getreg((3 << 11) | 20) & 0xFu; }
#define XB_SPIN(cond, bar) do { unsigned _sp = 0; while (cond) { __builtin_amdgcn_s_sleep(1); \
    if ((++_sp & 255u) == 0u) { if (xb_ld(&(bar)[XB_TMO])) break; if (_sp > XB_SPIN_CAP) { atomicAdd(&(bar)[XB_TMO], 1u); break; } } } } while (0)

struct XcdBarrier {
    unsigned* bar; unsigned x;
    volatile LAS unsigned* st;
};

__device__ __forceinline__ XcdBarrier xcd_barrier_post(unsigned* bar, volatile LAS unsigned* st) {
    XcdBarrier b; b.bar = bar; b.x = xb_xcc_id(); b.st = st;
    if (threadIdx.x == 0) (void)xb_add(&bar[XB_XCNT(b.x)], 1u);
    return b;
}
__device__ __forceinline__ void xcd_barrier_complete(unsigned* bar, unsigned x, unsigned& nloc, unsigned& nx) {
    const unsigned G = gridDim.x * gridDim.y * gridDim.z;
    unsigned sum, cnt, mine, sp = 0u;
    for (;;) {
        sum = 0u; cnt = 0u; mine = 0u;
#pragma unroll
        for (unsigned j = 0; j < 16; ++j) { const unsigned c = xb_ld(&bar[XB_XCNT(j)]); sum += c; cnt += (c > 0u) ? 1u : 0u; mine = (j == x) ? c : mine; }
        if (sum == G) break;
        __builtin_amdgcn_s_sleep(1);
        if ((++sp & 255u) == 0u) { if (xb_ld(&bar[XB_TMO])) break; if (sp > XB_SPIN_CAP) { atomicAdd(&bar[XB_TMO], 1u); break; } }
    }
    nloc = mine > 0u ? mine : 1u; nx = cnt > 0u ? cnt : 1u;
}

__device__ __forceinline__ void xcd_barrier(const XcdBarrier& b) {
    asm volatile("s_waitcnt vmcnt(0)" ::: "memory");
    __syncthreads();
    if (threadIdx.x == 0) {
        unsigned* bar = b.bar; asm volatile("" : "+s"(bar));
        __builtin_amdgcn_s_waitcnt(0);
        unsigned nloc = b.st[0], nx = b.st[1];
        if (nloc == 0u) { xcd_barrier_complete(bar, b.x, nloc, nx); b.st[0] = nloc; b.st[1] = nx; }
        const unsigned old = xb_add(&bar[XB_XSUB(b.x)], 1u);
        const unsigned gen = old / nloc;
        if (old + 1u == (gen + 1u) * nloc) {
            __builtin_amdgcn_fence(__ATOMIC_RELEASE, "agent");
            asm volatile("s_waitcnt vmcnt(0)" ::: "memory");
            const unsigned og = xb_add(&bar[XB_TOP], 1u);
            const unsigned tg = og / nx;
            if (og + 1u == (tg + 1u) * nx) xb_add(&bar[XB_TOPGEN], 1u);
            else XB_SPIN(xb_ld(&bar[XB_TOPGEN]) == tg, bar);
            __builtin_amdgcn_fence(__ATOMIC_ACQUIRE, "agent");
            xb_add(&bar[XB_XGEN(b.x)], 1u);
            asm volatile("s_waitcnt vmcnt(0)" ::: "memory");
        } else {
            XB_SPIN(xb_ld(&bar[XB_XGEN(b.x)]) == gen, bar);
            __builtin_amdgcn_fence(__ATOMIC_ACQUIRE, "agent");
            asm volatile("s_waitcnt vmcnt(0)" ::: "memory");
        }
    }
    __syncthreads();
}


__global__ void __launch_bounds__(NTHR) mk_forward(Params p) {
  extern __shared__ __attribute__((aligned(16))) char smem[];
  cg::grid_group grid = cg::this_grid();
  const bool never = (p.out == nullptr);
  unsigned* bar = (unsigned*)(p.ws + OFF_BAR);
  volatile LAS unsigned* xst = (volatile LAS unsigned*)((LAS unsigned char*)smem + LDS_RING);
  if (threadIdx.x < 4) xst[threadIdx.x] = 0u;
  if (blockIdx.x == 0) for (int i = threadIdx.x; i < 4096; i += NTHR) bar[i] = 0u;
  prologue_phase(p, smem);
  grid.sync();
  (void)xcd_barrier_post(bar, xst);
#define GRID_SYNC() do { XcdBarrier xb_; unsigned* bar_ = (unsigned*)(p.ws + OFF_BAR); asm volatile("" : "+s"(bar_)); unsigned x_ = xb_xcc_id(); asm volatile("" : "+s"(x_)); \
    xb_.bar = bar_; xb_.x = x_; xb_.st = (volatile LAS unsigned*)((LAS unsigned char*)smem + LDS_RING); xcd_barrier(xb_); } while (0)
  norm_phase(p, 0, 0);
  sw_phase(p);
  GRID_SYNC();
  for (int l = 0; l < NLAYER; ++l) {
    { pg8::Gemm g{(const bf16_t*)(p.ws + OFF_H), (const bf16_t*)(p.ws + OFF_WTIN) + (size_t)l * NPAD * 1024, NTOK, NPAD, 1024};
      pg8::StaticOrder S; S.init(NTOK, NPAD, (int)gridDim.x, (int)blockIdx.x);
      EpiInProj E{p.ws, p.g_qn + l * 64, p.g_kn + l * 64, (const float*)(p.ws + OFF_SW) + (size_t)l * 6 * NPAD};
      pg8::gemm_phase<EpiInProj, pg8::StaticOrder, true, true>((PG8_LAS unsigned char*)smem, g, S, E);
#if PROBE_GEMM2
      __syncthreads();
      pg8::gemm_phase<EpiInProj, pg8::StaticOrder, true, true>((PG8_LAS unsigned char*)smem, g, S, E);
#endif
    }
    GRID_SYNC();
    { pg8::Gemm g{(const bf16_t*)(p.ws + OFF_KVLAT), (const bf16_t*)(p.ws + OFF_WTUKV) + (size_t)l * 1024 * 128, NTOK, 1024, 128};
      pg8::StaticOrder S; S.init(NTOK, 1024, (int)gridDim.x, (int)blockIdx.x);
      EpiKvUp E{p.ws, l};
      pg8::gemm_phase<EpiKvUp, pg8::StaticOrder, true, true>((PG8_LAS unsigned char*)smem, g, S, E); }
    GRID_SYNC();
    if (PROBE_ATTN2) attn_phase(p, l, smem, never);
    attn_phase(p, l, smem);
    GRID_SYNC();
    { pg8::Gemm g{(const bf16_t*)(p.ws + OFF_G), (const bf16_t*)(p.ws + OFF_WTOUT) + (size_t)l * 1024 * 1024, NTOK, 1024, 1024};
      pg8::StaticOrder S; S.init(NTOK, 1024, (int)gridDim.x, (int)blockIdx.x);
      EpiOutProj E{p.x_prompt, p.x_sample, p.out, (const float*)(p.ws + OFF_MOD) + (size_t)l * 6 * 3072, l == 0 ? 1 : 0,
                   p.g_norm + (l + 1 < NLAYER ? l + 1 : l) * DM, (bf16_t*)(p.ws + OFF_H), (float*)(p.ws + OFF_SSQX), l + 1 < NLAYER ? 1 : 0};
      pg8::gemm_phase<EpiOutProj, pg8::StaticOrder, true, true>((PG8_LAS unsigned char*)smem, g, S, E); }
    GRID_SYNC();
  }
  norm_phase(p, 0, 1);
}

extern "C" void kernel_launch(void* const* d_in, const int* in_sizes, int n_in, void* d_out, int out_size, void* d_ws, size_t ws_size, hipStream_t stream) {
  static int grid_blocks = 0;
  if (!grid_blocks) {
    if (n_in != 16 || out_size != NTOK * DM || ws_size < WS_END) {
      fprintf(stderr, "kernel_launch: unexpected shapes n_in %d out %d ws %zu (need %zu)\n", n_in, out_size, ws_size, (size_t)WS_END); return; }
    if (hipFuncSetAttribute((const void*)mk_forward, hipFuncAttributeMaxDynamicSharedMemorySize, LDS_BYTES) != hipSuccess) {
      fprintf(stderr, "kernel_launch: hipFuncSetAttribute failed\n"); return; }
    int dev = 0, cus = 0, per_cu = 0;
    hipGetDevice(&dev);
    hipDeviceGetAttribute(&cus, hipDeviceAttributeMultiprocessorCount, dev);
    hipOccupancyMaxActiveBlocksPerMultiprocessor(&per_cu, mk_forward, NTHR, LDS_BYTES);
    if (per_cu < 1) { fprintf(stderr, "kernel_launch: occupancy 0\n"); return; }
    grid_blocks = cus;
  }
  Params p{};
  p.x_prompt = (const float*)d_in[0]; p.x_sample = (const float*)d_in[1]; p.c_prompt = (const float*)d_in[2]; p.c_sample = (const float*)d_in[3];
  p.w_ada = (const float*)d_in[4]; p.b_ada = (const float*)d_in[5]; p.g_norm = (const float*)d_in[6]; p.w_in = (const float*)d_in[7];
  p.g_qa = (const float*)d_in[8]; p.w_uq = (const float*)d_in[9]; p.g_kva = (const float*)d_in[10]; p.w_ukv = (const float*)d_in[11];
  p.g_qn = (const float*)d_in[12]; p.g_kn = (const float*)d_in[13]; p.w_out = (const float*)d_in[14]; p.g_final = (const float*)d_in[15];
  p.out = (float*)d_out; p.ws = (char*)d_ws;
  void* args[] = {&p};
  hipError_t e = hipLaunchCooperativeKernel((const void*)mk_forward, dim3(grid_blocks), dim3(NTHR), args, LDS_BYTES, stream);
  if (e != hipSuccess) fprintf(stderr, "cooperative launch failed: %s (grid %d)\n", hipGetErrorString(e), grid_blocks);
}
```

```cpp
#include <hip/hip_runtime.h>
#include <hip/hip_cooperative_groups.h>
#include <cstdio>
#include <cstdint>
namespace cg = cooperative_groups;
#ifndef PROBE_ATTN2
#define PROBE_ATTN2 0
#endif
#ifndef PROBE_GEMM2
#define PROBE_GEMM2 0
#endif
#ifndef PROBE_MISC2
#define PROBE_MISC2 0
#endif

typedef unsigned short bf16_t;
using bf16x8 = __attribute__((ext_vector_type(8))) short;
using s16x4  = __attribute__((ext_vector_type(4))) short;
using f32x16 = __attribute__((ext_vector_type(16))) float;
using f32x4  = __attribute__((ext_vector_type(4))) float;
using u32x4  = __attribute__((ext_vector_type(4))) unsigned;
using u32x2  = __attribute__((ext_vector_type(2))) unsigned;

constexpr int DM = 1024, NTOK = 32768, TOKP = 16384, NLAYER = 4, NPROJ = 2208, NPAD = 2304;
constexpr float EPS = 1e-6f;
constexpr float LOG2E = 1.4426950408889634f;
constexpr float C_GQA = 0.125f * LOG2E, C_MLA = 0.10206207261596575f * LOG2E;
constexpr int NTHR = 512;
constexpr size_t OFF_WTIN  = 0;
constexpr size_t OFF_WTUQ  = OFF_WTIN  + (size_t)4 * 2304 * 1024 * 2;
constexpr size_t OFF_WTUKV = OFF_WTUQ  + (size_t)4 * 768 * 256 * 2;
constexpr size_t OFF_WTOUT = OFF_WTUKV + (size_t)4 * 1024 * 128 * 2;
constexpr size_t OFF_MOD   = OFF_WTOUT + (size_t)4 * 1024 * 1024 * 2;
constexpr size_t OFF_ROPE  = OFF_MOD   + (size_t)4 * 6 * 3072 * 4;
constexpr size_t OFF_SSQQ  = OFF_ROPE  + (size_t)8192 * 16 * 8;
constexpr size_t OFF_SSQKV = OFF_SSQQ  + (size_t)NTOK * 4 * 4;
constexpr size_t OFF_G     = OFF_SSQKV + (size_t)NTOK * 4 * 4;
constexpr size_t OFF_QB    = OFF_G     + (size_t)NTOK * 1024 * 2;
constexpr size_t OFF_KB    = OFF_QB    + (size_t)NTOK * 512 * 2;
constexpr size_t OFF_VB    = OFF_KB    + (size_t)NTOK * 128 * 2;
constexpr size_t OFF_KROPE = OFF_VB    + (size_t)NTOK * 128 * 2;
constexpr size_t OFF_QLAT  = OFF_KROPE + (size_t)NTOK * 32 * 2;
constexpr size_t OFF_KVLAT = OFF_QLAT  + (size_t)NTOK * 256 * 2;
constexpr size_t OFF_H     = OFF_KVLAT + (size_t)NTOK * 128 * 2;
constexpr size_t OFF_KRSS  = OFF_H     + (size_t)NTOK * 1024 * 2;
constexpr size_t OFF_KMAX  = OFF_KRSS  + (size_t)NTOK * 4;
constexpr size_t OFF_BAR   = OFF_KMAX  + 1024;
constexpr size_t OFF_SSQX  = OFF_BAR   + 16384;
constexpr size_t OFF_SW    = OFF_SSQX  + (size_t)NTOK * 16 * 4;
constexpr size_t WS_END    = OFF_SW    + (size_t)4 * 6 * NPAD * 4;
constexpr int LDS_RING = 131072, LDS_BYTES = LDS_RING + 16;

struct Params {
  const float *x_prompt, *x_sample, *c_prompt, *c_sample, *w_ada, *b_ada, *g_norm, *w_in, *g_qa, *w_uq, *g_kva, *w_ukv, *g_qn, *g_kn, *w_out, *g_final;
  float* out; char* ws;
};

__device__ __forceinline__ unsigned cvtpk(float lo, float hi) { unsigned r; asm volatile("v_cvt_pk_bf16_f32 %0, %1, %2" : "=v"(r) : "v"(lo), "v"(hi)); return r; }
typedef __bf16 bf16x2_t __attribute__((ext_vector_type(2)));
typedef float f32x2_t __attribute__((ext_vector_type(2)));
__device__ __forceinline__ unsigned cvtpk_s(float lo, float hi) { f32x2_t v = {lo, hi}; bf16x2_t b = __builtin_convertvector(v, bf16x2_t); return __builtin_bit_cast(unsigned, b); }
__device__ __forceinline__ float bf2f(bf16_t v) { return __uint_as_float(((unsigned)v) << 16); }
__device__ __forceinline__ bf16_t f2bf(float f) { return (bf16_t)(cvtpk(f, f) & 0xffffu); }
__device__ __forceinline__ int crow(int r, int hi) { return (r & 3) + 8 * (r >> 2) + 4 * hi; }
#define SBAR() __builtin_amdgcn_sched_barrier(0)
#define LAS __attribute__((address_space(3)))
__device__ __forceinline__ int opaque_tid() { int t = threadIdx.x; asm volatile("" : "+v"(t)); return t; }
__device__ __forceinline__ int uni(int v) { return __builtin_amdgcn_readfirstlane(v); }

__device__ __forceinline__ void tok_info(int t, int& bb, int& s) {
  if (t < TOKP) { bb = t >> 12; s = t & 4095; } else { int u = t - TOKP; bb = 4 + (u >> 13); s = u & 8191; }
}
template <int NH> __device__ __forceinline__ int hm_row(int t, int h) {
  if (t < TOKP) { int b = t >> 12, s = t & 4095; return (b * NH + h) * 4096 + s; }
  int u = t - TOKP, b = u >> 13, s = u & 8191; return 4 * NH * 4096 + (b * NH + h) * 8192 + s;
}

__device__ __forceinline__ int in_srccol(int n) {
  if (n < 416) return n;
  if (n < 512) return -1;
  if (n < 1280) {
    const int q = n - 512, tq = q >> 8, p = q & 255, slot = (p >> 5) & 3, dim = (p >> 7) * 32 + (p & 31), lg = slot * 64 + dim;
    if (tq < 2) return 928 + tq * 256 + lg;
    return lg < 128 ? 1440 + lg : 1568 + (lg - 128);
  }
  if (n < 1792) return 416 + (n - 1280);
  return 1696 + (n - 1792);
}
__device__ __forceinline__ void transpose_item(const float* __restrict__ src, int ldn, int K, int k0, int n0, int mode, const float* __restrict__ gk,
                                               bf16_t* __restrict__ dst, float* lds) {
  const int tid = threadIdx.x, nn = tid & 63, kq = tid >> 6;
  const int sc = mode ? in_srccol(n0 + nn) : (n0 + nn);
#pragma unroll
  for (int i = 0; i < 8; ++i) {
    const int kk = kq + i * 8; float v = 0.f;
    if (sc >= 0) { v = src[(size_t)(k0 + kk) * ldn + sc]; if (gk) v *= gk[k0 + kk]; }
    lds[kk * 65 + nn] = v;
  }
  __syncthreads();
  const int kk2 = tid & 63;
#pragma unroll
  for (int i = 0; i < 8; ++i) { const int n2 = kq + i * 8; dst[(size_t)(n0 + n2) * K + k0 + kk2] = f2bf(lds[kk2 * 65 + n2]); }
  __syncthreads();
}

__device__ void prologue_phase(const Params& p, char* smem) {
  float* lds = (float*)smem;
  const int tid = threadIdx.x;
  bf16_t* WTIN = (bf16_t*)(p.ws + OFF_WTIN); bf16_t* WTUQ = (bf16_t*)(p.ws + OFF_WTUQ);
  bf16_t* WTUKV = (bf16_t*)(p.ws + OFF_WTUKV); bf16_t* WTOUT = (bf16_t*)(p.ws + OFF_WTOUT);
  for (int it = blockIdx.x; it < 4 * 912; it += gridDim.x) {
    const int l = it / 912, r = it % 912;
    if (r < 576) { const int kt = r / 36, nt = r % 36;
      transpose_item(p.w_in + (size_t)l * 1024 * NPROJ, NPROJ, 1024, kt * 64, nt * 64, 1, nullptr, WTIN + (size_t)l * NPAD * 1024, lds);
    } else if (r < 624) { const int q = r - 576, kt = q / 12, nt = q % 12;
      transpose_item(p.w_uq + (size_t)l * 256 * 768, 768, 256, kt * 64, nt * 64, 0, p.g_qa + l * 256, WTUQ + (size_t)l * 768 * 256, lds);
    } else if (r < 656) { const int q = r - 624, kt = q / 16, nt = q % 16;
      transpose_item(p.w_ukv + (size_t)l * 128 * 1024, 1024, 128, kt * 64, nt * 64, 0, p.g_kva + l * 128, WTUKV + (size_t)l * 1024 * 128, lds);
    } else { const int q = r - 656, kt = q / 16, nt = q % 16;
      transpose_item(p.w_out + (size_t)l * 1024 * 1024, 1024, 1024, kt * 64, nt * 64, 0, nullptr, WTOUT + (size_t)l * 1024 * 1024, lds);
    }
  }
  float* MOD = (float*)(p.ws + OFF_MOD);
  for (int it = blockIdx.x; it < 4 * 48; it += gridDim.x) {
    const int l = it / 48, n0 = (it % 48) * 64;
    float* sc = lds; float* red = lds + 6144;
    for (int i = tid; i < 6144; i += NTHR) { const int bb = i >> 10, k = i & 1023;
      const float c = bb < 4 ? p.c_prompt[bb * 1024 + k] : p.c_sample[(bb - 4) * 1024 + k];
      sc[i] = c / (1.f + __expf(-c)); }
    __syncthreads();
    const int g = tid >> 6, c = tid & 63;
    float a0 = 0, a1 = 0, a2 = 0, a3 = 0, a4 = 0, a5 = 0;
    const float* wp = p.w_ada + ((size_t)l * 1024 + g * 128) * 3072 + n0 + c;
#pragma unroll 16
    for (int k = 0; k < 128; ++k) { const float w = wp[(size_t)k * 3072]; const int kk = g * 128 + k;
      a0 += sc[kk] * w; a1 += sc[1024 + kk] * w; a2 += sc[2048 + kk] * w; a3 += sc[3072 + kk] * w; a4 += sc[4096 + kk] * w; a5 += sc[5120 + kk] * w; }
    red[(g * 6 + 0) * 64 + c] = a0; red[(g * 6 + 1) * 64 + c] = a1; red[(g * 6 + 2) * 64 + c] = a2;
    red[(g * 6 + 3) * 64 + c] = a3; red[(g * 6 + 4) * 64 + c] = a4; red[(g * 6 + 5) * 64 + c] = a5;
    __syncthreads();
    if (tid < 384) { const int bb = tid >> 6; float s = 0.f;
#pragma unroll
      for (int gg = 0; gg < 8; ++gg) s += red[(gg * 6 + bb) * 64 + c];
      MOD[(size_t)(l * 6 + bb) * 3072 + n0 + c] = s + p.b_ada[l * 3072 + n0 + c]; }
    __syncthreads();
  }
  if (blockIdx.x == 0 && tid < 192) ((unsigned*)(p.ws + OFF_KMAX))[tid] = 0u;
  float2* ROPE = (float2*)(p.ws + OFF_ROPE);
  for (int it = blockIdx.x; it < 256; it += gridDim.x) {
    const int e = it * 512 + tid, pos = e >> 4, i = e & 15, a = i >> 2, b = i & 3;
    const double pa = a == 0 ? 1.0 : a == 1 ? 0.1 : a == 2 ? 0.01 : 0.001;
    const double pb = b == 0 ? 1.0 : b == 1 ? 0.5623413251903491 : b == 2 ? 0.31622776601683794 : 0.17782794100389228;
    double rev = (double)pos * (pa * pb) * 0.15915494309189535;
    rev -= floor(rev);
    const float fr = (float)rev;
    ROPE[e] = make_float2(__builtin_amdgcn_cosf(fr), __builtin_amdgcn_sinf(fr));
  }
}

__device__ void norm_phase(const Params& p, int l, int mode) {
  const int tid = opaque_tid(), wid = uni(tid >> 6), lane = tid & 63;
  const float* MOD = (const float*)(p.ws + OFF_MOD);
  bf16_t* H = (bf16_t*)(p.ws + OFF_H);
#define XROW(r) ((mode == 0 && l == 0) ? ((r) < TOKP ? p.x_prompt + (size_t)(r) * DM : p.x_sample + (size_t)((r) - TOKP) * DM) : p.out + (size_t)(r) * DM)
  const int rstride = gridDim.x * 8;
  f32x4 v[4], nv[4];
  { const int r0 = blockIdx.x * 8 + wid; if (r0 < NTOK) { const float* xr = XROW(r0);
#pragma unroll
      for (int i = 0; i < 4; ++i) v[i] = ((const f32x4*)xr)[i * 64 + lane]; } }
  for (int row = blockIdx.x * 8 + wid; row < NTOK; row += rstride) {
    const int nrow = row + rstride;
    if (nrow < NTOK) { const float* xn = XROW(nrow);
#pragma unroll
      for (int i = 0; i < 4; ++i) nv[i] = ((const f32x4*)xn)[i * 64 + lane]; }
    float ss = 0.f;
#pragma unroll
    for (int i = 0; i < 4; ++i) ss += v[i][0] * v[i][0] + v[i][1] * v[i][1] + v[i][2] * v[i][2] + v[i][3] * v[i][3];
#pragma unroll
    for (int off = 32; off >= 1; off >>= 1) ss += __shfl_xor(ss, off);
    const float rstd = rsqrtf(ss * (1.f / 1024.f) + EPS);
    if (mode == 1) {
#pragma unroll
      for (int i = 0; i < 4; ++i) { const f32x4 g = ((const f32x4*)p.g_final)[i * 64 + lane];
        f32x4 o; o[0] = v[i][0] * rstd * g[0]; o[1] = v[i][1] * rstd * g[1]; o[2] = v[i][2] * rstd * g[2]; o[3] = v[i][3] * rstd * g[3];
        ((f32x4*)(p.out + (size_t)row * DM))[i * 64 + lane] = o; }
    } else {
      int bb, s; tok_info(row, bb, s);
      const float* md = MOD + (size_t)(l * 6 + bb) * 3072;
#pragma unroll
      for (int i = 0; i < 4; ++i) { const int ci = i * 64 + lane;
        const f32x4 g = ((const f32x4*)(p.g_norm + l * DM))[ci], sc = ((const f32x4*)(md + 1024))[ci];
        const float h0 = v[i][0] * g[0] * (1.f + sc[0]), h1 = v[i][1] * g[1] * (1.f + sc[1]);
        const float h2 = v[i][2] * g[2] * (1.f + sc[2]), h3 = v[i][3] * g[3] * (1.f + sc[3]);
        u32x2 w; w[0] = cvtpk(h0, h1); w[1] = cvtpk(h2, h3);
        *(u32x2*)(H + (size_t)row * DM + ci * 4) = w; }
      if (lane < 4) { f32x4 z = {0.f, 0.f, 0.f, 0.f}; if (lane == 0) z[0] = ss; ((f32x4*)(p.ws + OFF_SSQX))[(size_t)row * 4 + lane] = z; }
    }
#pragma unroll
    for (int i = 0; i < 4; ++i) v[i] = nv[i];
  }
#undef XROW
}


__device__ void sw_phase(const Params& p) {
  const int tid = opaque_tid(), wid = uni(tid >> 6), lane = tid & 63;
  const float* MOD = (const float*)(p.ws + OFF_MOD);
  const bf16_t* WTIN = (const bf16_t*)(p.ws + OFF_WTIN);
  float* SW = (float*)(p.ws + OFF_SW);
  for (int r = blockIdx.x * 8 + wid; r < 4 * NPAD; r += gridDim.x * 8) {
    const int l = r / NPAD, n = r % NPAD;
    const bf16_t* wr = WTIN + ((size_t)l * NPAD + n) * 1024 + lane * 16;
    const u32x4 w0 = *(const u32x4*)wr, w1 = *(const u32x4*)(wr + 8);
    float wf[16];
#pragma unroll
    for (int i = 0; i < 4; ++i) { wf[2 * i] = __uint_as_float(w0[i] << 16); wf[2 * i + 1] = __uint_as_float(w0[i] & 0xffff0000u);
      wf[8 + 2 * i] = __uint_as_float(w1[i] << 16); wf[8 + 2 * i + 1] = __uint_as_float(w1[i] & 0xffff0000u); }
#pragma unroll
    for (int bb = 0; bb < 6; ++bb) { const float* sh = MOD + (size_t)(l * 6 + bb) * 3072 + lane * 16; float a = 0.f;
#pragma unroll
      for (int i = 0; i < 4; ++i) { const f32x4 s4 = ((const f32x4*)sh)[i]; a += s4[0] * wf[4 * i] + s4[1] * wf[4 * i + 1] + s4[2] * wf[4 * i + 2] + s4[3] * wf[4 * i + 3]; }
#pragma unroll
      for (int off = 32; off >= 1; off >>= 1) a += __shfl_xor(a, off);
      if (lane == 0) SW[(size_t)(l * 6 + bb) * NPAD + n] = a; }
  }
}

#define GOFF(row, chunk) ((row) * 128 + ((((chunk)) ^ (((row) >> 1) & 7)) << 4))
enum { EPI_INPROJ = 0, EPI_KVUP = 1, EPI_OUT = 2 };

__device__ __forceinline__ void rope4(f32x4& x1, f32x4& x2, const float2* __restrict__ rp) {
  const f32x4 c01 = ((const f32x4*)rp)[0], c23 = ((const f32x4*)rp)[1];
  const float cs[4] = {c01[0], c01[2], c23[0], c23[2]}, sn[4] = {c01[1], c01[3], c23[1], c23[3]};
#pragma unroll
  for (int j = 0; j < 4; ++j) { const float a = x1[j], b = x2[j]; x1[j] = a * cs[j] - b * sn[j]; x2[j] = a * sn[j] + b * cs[j]; }
}
__device__ __forceinline__ void st_bf4(bf16_t* dst, const f32x4& v) { u32x2 w; w[0] = cvtpk(v[0], v[1]); w[1] = cvtpk(v[2], v[3]); *(u32x2*)dst = w; }
__device__ __forceinline__ float silu_f(float z) { return z * __builtin_amdgcn_rcpf(1.f + __builtin_amdgcn_exp2f(-1.4426950408889634f * z)); }

template <int EPI>
__device__ __forceinline__ void gemm_epilogue(const Params& p, int l, f32x4 (&acc)[4][4], int row0, int col0, int wr, int wc, int fr, int fq) {
  const int rbase = row0 + wr * 64 + fr;
  const int cw = col0 + wc * 64 + fq * 4;
  if constexpr (EPI == EPI_OUT) {
    const float* MOD = (const float*)(p.ws + OFF_MOD);
    int bb, s0; tok_info(row0, bb, s0);
    const float* gate = MOD + (size_t)(l * 6 + bb) * 3072 + 2048;
#pragma unroll
    for (int m = 0; m < 4; ++m) { const int t = rbase + m * 16;
      const float* xo = (l == 0) ? (t < TOKP ? p.x_prompt + (size_t)t * DM : p.x_sample + (size_t)(t - TOKP) * DM) : p.out + (size_t)t * DM;
#pragma unroll
      for (int n = 0; n < 4; ++n) { const int c = cw + n * 16; const f32x4 g = *(const f32x4*)(gate + c), x = *(const f32x4*)(xo + c);
        f32x4 o; o[0] = x[0] + g[0] * acc[m][n][0]; o[1] = x[1] + g[1] * acc[m][n][1]; o[2] = x[2] + g[2] * acc[m][n][2]; o[3] = x[3] + g[3] * acc[m][n][3];
        *(f32x4*)(p.out + (size_t)t * DM + c) = o; } }
  } else if constexpr (EPI == EPI_KVUP) {
    const float* SSQKV = (const float*)(p.ws + OFF_SSQKV);
    const float* KRSS = (const float*)(p.ws + OFF_KRSS);
    bf16_t* KVA = (bf16_t*)(p.ws + OFF_H);
    const int head = col0 >> 7;
    float kmx = 0.f;
#pragma unroll
    for (int m = 0; m < 4; ++m) { const int t = rbase + m * 16;
      const f32x4 sq = *(const f32x4*)(SSQKV + (size_t)t * 4);
      const float rstd = rsqrtf((sq[0] + sq[1] + sq[2] + sq[3]) * (1.f / 128.f) + EPS);
      bf16_t* dst = KVA + (size_t)hm_row<8>(t, head) * 128 + wc * 64 + fq * 4;
      float ss = 0.f;
#pragma unroll
      for (int n = 0; n < 4; ++n) { f32x4 v = acc[m][n] * rstd; ss += v[0] * v[0] + v[1] * v[1] + v[2] * v[2] + v[3] * v[3]; st_bf4(dst + n * 16, v); }
      ss += __shfl_xor(ss, 16); ss += __shfl_xor(ss, 32);
      kmx = fmaxf(kmx, ss + KRSS[t]); }
    if (wc == 0) {
#pragma unroll
      for (int off = 1; off < 16; off <<= 1) kmx = fmaxf(kmx, __shfl_xor(kmx, off));
      int bb, s0; tok_info(row0, bb, s0);
      if (fr == 0 && fq == 0) atomicMax((unsigned*)(p.ws + OFF_KMAX) + (l * 6 + bb) * 8 + head, __float_as_uint(kmx));
    }
  } else {
    const int ct = col0 >> 7;
    const float2* ROPE = (const float2*)(p.ws + OFF_ROPE);
    if (ct < 3) {
      bf16_t* dstb = ct < 2 ? (bf16_t*)(p.ws + OFF_QLAT) : (bf16_t*)(p.ws + OFF_KVLAT);
      const int ld = ct < 2 ? 256 : 128, cb = (ct < 2 ? col0 : 0) + wc * 64 + fq * 4;
      float* ssq = ct < 2 ? (float*)(p.ws + OFF_SSQQ) : (float*)(p.ws + OFF_SSQKV);
      const int sst = ct < 2 ? 4 : 2, sidx = (ct < 2 ? ct * 2 : 0) + wc;
#pragma unroll
      for (int m = 0; m < 4; ++m) { const int t = rbase + m * 16; float ss = 0.f;
#pragma unroll
        for (int n = 0; n < 4; ++n) { const f32x4 v = acc[m][n]; ss += v[0] * v[0] + v[1] * v[1] + v[2] * v[2] + v[3] * v[3]; st_bf4(dstb + (size_t)t * ld + cb + n * 16, v); }
        ss += __shfl_xor(ss, 16); ss += __shfl_xor(ss, 32);
        if (fq == 0) ssq[t * sst + sidx] = ss; }
    } else if (ct == 3) {
      if (wc == 0) { bf16_t* KR = (bf16_t*)(p.ws + OFF_KROPE);
#pragma unroll
        for (int m = 0; m < 4; ++m) { const int t = rbase + m * 16; int bb, s; tok_info(t, bb, s);
          f32x4 x1 = acc[m][0], x2 = acc[m][1]; rope4(x1, x2, ROPE + s * 16 + fq * 4);
          st_bf4(KR + (size_t)t * 32 + fq * 4, x1); st_bf4(KR + (size_t)t * 32 + 16 + fq * 4, x2); } }
    } else if (ct < 9) {
      const float* gv = (ct < 8 ? p.g_qn : p.g_kn) + l * 64;
      f32x4 g[4];
#pragma unroll
      for (int n = 0; n < 4; ++n) g[n] = *(const f32x4*)(gv + n * 16 + fq * 4);
#pragma unroll
      for (int m = 0; m < 4; ++m) { const int t = rbase + m * 16; int bb, s; tok_info(t, bb, s); float ss = 0.f;
#pragma unroll
        for (int n = 0; n < 4; ++n) { const f32x4 v = acc[m][n]; ss += v[0] * v[0] + v[1] * v[1] + v[2] * v[2] + v[3] * v[3]; }
        ss += __shfl_xor(ss, 16); ss += __shfl_xor(ss, 32);
        const float rstd = rsqrtf(ss * (1.f / 64.f) + EPS);
        f32x4 y[4];
#pragma unroll
        for (int n = 0; n < 4; ++n) { y[n][0] = acc[m][n][0] * rstd * g[n][0]; y[n][1] = acc[m][n][1] * rstd * g[n][1]; y[n][2] = acc[m][n][2] * rstd * g[n][2]; y[n][3] = acc[m][n][3] * rstd * g[n][3]; }
        rope4(y[0], y[1], ROPE + (s >> 6) * 16 + fq * 4);
        rope4(y[2], y[3], ROPE + (s & 63) * 16 + fq * 4);
        bf16_t* dst = ct < 8 ? (bf16_t*)(p.ws + OFF_QB) + (size_t)t * 512 + (col0 - 512) + wc * 64 + fq * 4
                             : (bf16_t*)(p.ws + OFF_KB) + (size_t)hm_row<2>(t, wc) * 64 + fq * 4;
#pragma unroll
        for (int n = 0; n < 4; ++n) st_bf4(dst + n * 16, y[n]); }
    } else if (ct == 9) {
#pragma unroll
      for (int m = 0; m < 4; ++m) { const int t = rbase + m * 16;
        bf16_t* dst = (bf16_t*)(p.ws + OFF_VB) + (size_t)hm_row<2>(t, wc) * 64 + fq * 4;
#pragma unroll
        for (int n = 0; n < 4; ++n) st_bf4(dst + n * 16, acc[m][n]); }
    } else {
      bf16_t* G = (bf16_t*)(p.ws + OFF_G);
#pragma unroll
      for (int m = 0; m < 4; ++m) { const int t = rbase + m * 16;
#pragma unroll
        for (int n = 0; n < 4; ++n) { f32x4 v; v[0] = silu_f(acc[m][n][0]); v[1] = silu_f(acc[m][n][1]); v[2] = silu_f(acc[m][n][2]); v[3] = silu_f(acc[m][n][3]);
          st_bf4(G + (size_t)t * 1024 + (cw - 1280) + n * 16, v); } }
    }
  }
}

template <int EPI>
__device__ __forceinline__ void gemm_tile(const Params& p, int l, const bf16_t* __restrict__ A, int lda, const bf16_t* __restrict__ Bt, int ldb, int K,
                                          int row0, int col0, char* lds, bool live = true) {
  const int tid = opaque_tid(), wid = uni(tid >> 6), lane = tid & 63, fr = lane & 15, fq = lane >> 4, wr = wid >> 1, wc = wid & 1;
  f32x4 acc[4][4];
#pragma unroll
  for (int m = 0; m < 4; ++m)
#pragma unroll
    for (int n = 0; n < 4; ++n) acc[m][n] = (f32x4){0.f, 0.f, 0.f, 0.f};
  const int sr = tid >> 3, sc = tid & 7;
  const bf16_t* Ag = A + (size_t)(row0 + sr) * lda + sc * 8;
  const bf16_t* Bg = Bt + (size_t)(col0 + sr) * ldb + sc * 8;
  u32x4 sa0, sa1, sa2, sa3, sb0, sb1;
#define GLOAD(kt) do { const int ko = (kt) * 64; sa0 = *(const u32x4*)(Ag + ko); sa1 = *(const u32x4*)(Ag + (size_t)64 * lda + ko); \
    sa2 = *(const u32x4*)(Ag + (size_t)128 * lda + ko); sa3 = *(const u32x4*)(Ag + (size_t)192 * lda + ko); \
    sb0 = *(const u32x4*)(Bg + ko); sb1 = *(const u32x4*)(Bg + (size_t)64 * ldb + ko); } while (0)
#define LWRITE(b) do { char* ab = lds + (b) * 49152; char* bbp = ab + 32768; \
    *(u32x4*)(ab + GOFF(sr, sc)) = sa0; *(u32x4*)(ab + GOFF(sr + 64, sc)) = sa1; *(u32x4*)(ab + GOFF(sr + 128, sc)) = sa2; *(u32x4*)(ab + GOFF(sr + 192, sc)) = sa3; \
    *(u32x4*)(bbp + GOFF(sr, sc)) = sb0; *(u32x4*)(bbp + GOFF(sr + 64, sc)) = sb1; } while (0)
  const int nk = K >> 6;
  GLOAD(0); LWRITE(0); __syncthreads();
  for (int kt = 0; kt < nk; ++kt) {
    const int cur = kt & 1;
    if (kt + 1 < nk) GLOAD(kt + 1);
    const char* ab = lds + cur * 49152; const char* bbp = ab + 32768;
#pragma unroll
    for (int kk = 0; kk < 2; ++kk) {
      bf16x8 af[4], bfr[4];
#pragma unroll
      for (int m = 0; m < 4; ++m) { const int row = wr * 64 + m * 16 + fr; af[m] = *(const bf16x8*)(ab + GOFF(row, kk * 4 + fq)); }
#pragma unroll
      for (int n = 0; n < 4; ++n) { const int row = wc * 64 + n * 16 + fr; bfr[n] = *(const bf16x8*)(bbp + GOFF(row, kk * 4 + fq)); }
#pragma unroll
      for (int m = 0; m < 4; ++m)
#pragma unroll
        for (int n = 0; n < 4; ++n) acc[m][n] = __builtin_amdgcn_mfma_f32_16x16x32_bf16(bfr[n], af[m], acc[m][n], 0, 0, 0);
    }
    if (kt + 1 < nk) LWRITE(cur ^ 1);
    __syncthreads();
  }
#undef GLOAD
#undef LWRITE
  if (live) gemm_epilogue<EPI>(p, l, acc, row0, col0, wr, wc, fr, fq);
}


namespace pg8 {
#define PG8_LAS __attribute__((address_space(3)))
typedef unsigned short bf16_t;
typedef short bf16x8 __attribute__((ext_vector_type(8)));
typedef float f32x4 __attribute__((ext_vector_type(4)));
typedef unsigned u32x4 __attribute__((ext_vector_type(4)));
constexpr int BM = 256, BK = 64, HALF = 128, HTB = HALF * BK * 2  , STAGE_BYTES = 8 * HTB, NXCD = 8, WGM = 8;

__host__ __device__ __forceinline__ int lds_byte(int r, int c) { const int st = (r >> 4) * 2 + (c >> 5), rr = r & 15, cc = c & 31, ob = rr * 64 + cc * 2; return st * 1024 + (ob ^ (((ob >> 9) & 1) << 5)); }
__host__ __device__ __forceinline__ void stage_rc(int b, int& R, int& C) { const int st = b / 1024, sb = b % 1024, swz = sb ^ (((sb >> 9) & 1) << 5); R = (st >> 1) * 16 + swz / 64; C = (st & 1) * 32 + (swz % 64) / 2; }
__host__ __device__ __forceinline__ int perm32(int rho) { const int n = rho >> 4, i = rho & 15; return 8 * (i >> 2) + 4 * n + (i & 3); }

struct Unit { int pm, pn; };
struct Gemm { const bf16_t* A; const bf16_t* Bt; int M, N, K; };

struct StaticOrder {
    int nM, nN, nwg, G, c;
    __host__ __device__ void init(int M, int N, int G_, int c_) { nM = M / BM; nN = N / BM; nwg = nM * nN; G = G_; c = c_; }
    __host__ __device__ bool next(int i, Unit& u) const {
        const long L = (long)i * G + c; if (L >= nwg) return false;
        int wgid = (int)L; { const int q = nwg / NXCD, r = nwg % NXCD, xcd = wgid % NXCD, off = wgid / NXCD; wgid = (xcd < r ? xcd * (q + 1) : r * (q + 1) + (xcd - r) * q) + off; }
        const int nig = WGM * nN, gid = wgid / nig, fm = gid * WGM, gsz = (nM - fm) < WGM ? (nM - fm) : WGM;
        u.pm = fm + ((wgid % nig) % gsz); u.pn = (wgid % nig) / gsz; return true;
    }
    __device__ __forceinline__ void a_ready(const Unit&) const {}
    __device__ __forceinline__ void done(const Unit&) const {}
};

template <class Epi, class Sched, bool ALIGN_EPI = false, bool SP2 = false>
__device__ __forceinline__ void gemm_phase(PG8_LAS unsigned char* lds, const Gemm g, const Sched& S, const Epi& E) {
    const int tid = opaque_tid(), wid = __builtin_amdgcn_readfirstlane(tid >> 6), lane = tid & 63, wr = wid >> 2, wc = wid & 3, fr = lane & 15, fq = lane >> 4;
    const int K = g.K, nt = K / BK;
    unsigned voffA[2], voffB[2];
#pragma unroll
    for (int i = 0; i < 2; ++i) { int R, C; stage_rc(tid * 16 + i * 8192, R, C); const int Rb = Epi::PERM ? ((R & ~31) + perm32(R & 31)) : R;
        voffA[i] = (unsigned)(R * K + C) * 2u; voffB[i] = (unsigned)(Rb * K + C) * 2u; }
    const size_t kstep = (size_t)(BK * 2);
    const size_t hstep = (size_t)HALF * K * 2;
    const size_t tstep = 2 * hstep;
    const unsigned ldsw = (unsigned)wid * 1024u;
    const int aoff = lds_byte(wr * 64 + fr, fq * 8), boff = lds_byte(wc * 32 + fr, fq * 8);
#define PG8_SA(b, h) (((b) * 2 + (h)) * HTB)
#define PG8_SB(b, h) ((4 + (b) * 2 + (h)) * HTB)
#define PG8_STAGE(bufoff, gbase, voff) do { _Pragma("unroll") for (int _i = 0; _i < 2; ++_i) \
        __builtin_amdgcn_global_load_lds((const unsigned*)((const char*)(gbase) + (voff)[_i]), (PG8_LAS unsigned*)(lds + (bufoff) + ldsw + _i * 8192), 16, 0, 0); } while (0)
#define PG8_LDA(dst, b, h) do { _Pragma("unroll") for (int m = 0; m < 4; ++m) _Pragma("unroll") for (int k = 0; k < 2; ++k) dst[m][k] = *(const PG8_LAS bf16x8*)(lds + PG8_SA(b, h) + aoff + m * 2048 + k * 1024); } while (0)
#define PG8_LDB(dst, b, h) do { _Pragma("unroll") for (int n = 0; n < 2; ++n) _Pragma("unroll") for (int k = 0; k < 2; ++k) dst[n][k] = *(const PG8_LAS bf16x8*)(lds + PG8_SB(b, h) + boff + n * 2048 + k * 1024); } while (0)
#define PG8_MMA(ai, bj, At, Bt) do { __builtin_amdgcn_s_setprio(1); _Pragma("unroll") for (int m = 0; m < 4; ++m) _Pragma("unroll") for (int n = 0; n < 2; ++n) _Pragma("unroll") for (int k = 0; k < 2; ++k) \
        acc[ai][bj][m][n] = __builtin_amdgcn_mfma_f32_16x16x32_bf16(Bt[n][k], At[m][k], acc[ai][bj][m][n], 0, 0, 0); __builtin_amdgcn_s_setprio(0); } while (0)
#define PG8_WAIT_V(n) asm volatile("s_waitcnt vmcnt(" #n ")" ::: "memory")
#define PG8_WAIT_L(n) asm volatile("s_waitcnt lgkmcnt(" #n ")" ::: "memory")
#define PG8_BAR __builtin_amdgcn_s_barrier()
#define PG8_SCHED __builtin_amdgcn_sched_barrier(0)
    Unit cur, nxt; int ui = 0;
    if (!S.next(0, cur)) return;
    f32x4 acc[2][2][4][2];
#pragma unroll
    for (int a = 0; a < 2; ++a)
#pragma unroll
        for (int b = 0; b < 2; ++b)
#pragma unroll
            for (int m = 0; m < 4; ++m)
#pragma unroll
                for (int n = 0; n < 2; ++n) acc[a][b][m][n] = (f32x4){0.f, 0.f, 0.f, 0.f};
    bf16x8 At[4][2], B0[2][2], B1[2][2];
    const char* cA = (const char*)g.A + (size_t)cur.pm * tstep; const char* cB = (const char*)g.Bt + (size_t)cur.pn * tstep;
    S.a_ready(cur);
    if constexpr (SP2) {
        PG8_STAGE(PG8_SB(0, 0), cB, voffB); PG8_STAGE(PG8_SB(0, 1), cB + hstep, voffB); PG8_STAGE(PG8_SA(0, 0), cA, voffA); PG8_STAGE(PG8_SA(0, 1), cA + hstep, voffA);
        if (wr == 1) PG8_BAR;
        PG8_WAIT_V(2); PG8_BAR;
        PG8_STAGE(PG8_SB(1, 0), cB + kstep, voffB); PG8_STAGE(PG8_SA(1, 0), cA + kstep, voffA); PG8_STAGE(PG8_SB(1, 1), cB + hstep + kstep, voffB);
        PG8_WAIT_V(6); PG8_BAR;
    } else {
        PG8_STAGE(PG8_SB(0, 0), cB, voffB); PG8_STAGE(PG8_SA(0, 0), cA, voffA); PG8_STAGE(PG8_SB(0, 1), cB + hstep, voffB); PG8_STAGE(PG8_SA(0, 1), cA + hstep, voffA);
        if (wr == 1) PG8_BAR;
        PG8_WAIT_V(4); PG8_BAR;
        PG8_STAGE(PG8_SB(1, 0), cB + kstep, voffB); PG8_STAGE(PG8_SA(1, 0), cA + kstep, voffA); PG8_STAGE(PG8_SB(1, 1), cB + hstep + kstep, voffB);
        PG8_WAIT_V(6); PG8_BAR;
    }
    for (;;) {
        const bool has_next = S.next(ui + 1, nxt);
        const char* nA = has_next ? (const char*)g.A + (size_t)nxt.pm * tstep : cA; const char* nB = has_next ? (const char*)g.Bt + (size_t)nxt.pn * tstep : cB;
        for (int t = 0; t < nt; t += 2) {
            const bool last = (t == nt - 2);
            const char* a1 = cA + (size_t)(t + 1) * kstep;
            const char* a2 = last ? nA : cA + (size_t)(t + 2) * kstep; const char* b2 = last ? nB : cB + (size_t)(t + 2) * kstep;
            const char* a3 = a2 + kstep; const char* b3 = b2 + kstep;
            if (last && has_next) S.a_ready(nxt);
            if constexpr (SP2) {
            PG8_LDB(B0, 0, 0); PG8_LDB(B1, 0, 1); PG8_SCHED; PG8_LDA(At, 0, 0); PG8_STAGE(PG8_SA(1, 1), a1 + hstep, voffA);
            PG8_WAIT_V(8); PG8_WAIT_L(0); PG8_BAR; PG8_MMA(0, 0, At, B0); PG8_MMA(0, 1, At, B1); PG8_BAR; PG8_SCHED;
            PG8_LDA(At, 0, 1); PG8_STAGE(PG8_SB(0, 0), b2, voffB); PG8_STAGE(PG8_SB(0, 1), b2 + hstep, voffB); PG8_STAGE(PG8_SA(0, 0), a2, voffA);
            PG8_WAIT_V(8); PG8_WAIT_L(0); PG8_BAR; PG8_MMA(1, 0, At, B0); PG8_MMA(1, 1, At, B1); PG8_BAR; PG8_SCHED;
            PG8_LDB(B0, 1, 0); PG8_LDB(B1, 1, 1); PG8_SCHED; PG8_LDA(At, 1, 0); PG8_STAGE(PG8_SA(0, 1), a2 + hstep, voffA);
            PG8_WAIT_V(8); PG8_WAIT_L(0); PG8_BAR; PG8_MMA(0, 0, At, B0); PG8_MMA(0, 1, At, B1); PG8_BAR; PG8_SCHED;
            PG8_LDA(At, 1, 1); PG8_STAGE(PG8_SB(1, 0), b3, voffB); PG8_STAGE(PG8_SB(1, 1), b3 + hstep, voffB); PG8_STAGE(PG8_SA(1, 0), a3, voffA);
            PG8_WAIT_V(8); PG8_WAIT_L(0); PG8_BAR; PG8_MMA(1, 0, At, B0); PG8_MMA(1, 1, At, B1); PG8_BAR; PG8_SCHED;
            } else {
            PG8_LDB(B0, 0, 0); PG8_SCHED; PG8_LDA(At, 0, 0); PG8_STAGE(PG8_SA(1, 1), a1 + hstep, voffA);
            PG8_WAIT_L(8); PG8_BAR; PG8_WAIT_L(0); PG8_MMA(0, 0, At, B0); PG8_BAR; PG8_SCHED;
            PG8_LDB(B1, 0, 1); PG8_STAGE(PG8_SB(0, 0), b2, voffB);
            PG8_BAR; PG8_WAIT_L(0); PG8_MMA(0, 1, At, B1); PG8_BAR;
            PG8_LDA(At, 0, 1); PG8_STAGE(PG8_SA(0, 0), a2, voffA);
            PG8_BAR; PG8_WAIT_L(0); PG8_MMA(1, 0, At, B0); PG8_BAR; PG8_SCHED;
            PG8_STAGE(PG8_SB(0, 1), b2 + hstep, voffB);
            PG8_WAIT_V(6); PG8_BAR; PG8_MMA(1, 1, At, B1); PG8_BAR;
            PG8_LDB(B0, 1, 0); PG8_SCHED; PG8_LDA(At, 1, 0); PG8_STAGE(PG8_SA(0, 1), a2 + hstep, voffA);
            PG8_WAIT_L(8); PG8_BAR; PG8_WAIT_L(0); PG8_MMA(0, 0, At, B0); PG8_BAR; PG8_SCHED;
            PG8_LDB(B1, 1, 1); PG8_STAGE(PG8_SB(1, 0), b3, voffB);
            PG8_BAR; PG8_WAIT_L(0); PG8_MMA(0, 1, At, B1); PG8_BAR;
            PG8_LDA(At, 1, 1); PG8_STAGE(PG8_SA(1, 0), a3, voffA);
            PG8_BAR; PG8_WAIT_L(0); PG8_MMA(1, 0, At, B0); PG8_BAR; PG8_SCHED;
            PG8_STAGE(PG8_SB(1, 1), b3 + hstep, voffB);
            PG8_WAIT_V(6); PG8_BAR; PG8_MMA(1, 1, At, B1); PG8_BAR;
            }
        }
        if constexpr (ALIGN_EPI) { if (wr == 0) PG8_BAR; }
        if constexpr (!Epi::AFTER_DRAIN) { E(acc, cur, wr, wc, fr, fq); S.done(cur); }
        if (!has_next) break;
#pragma unroll
        for (int a = 0; a < 2; ++a)
#pragma unroll
            for (int b = 0; b < 2; ++b)
#pragma unroll
                for (int m = 0; m < 4; ++m)
#pragma unroll
                    for (int n = 0; n < 2; ++n) acc[a][b][m][n] = (f32x4){0.f, 0.f, 0.f, 0.f};
        cur = nxt; cA = nA; cB = nB; ++ui;
        if constexpr (ALIGN_EPI) { if (wr == 1) PG8_BAR; }
    }
    PG8_WAIT_V(0);
    if constexpr (!ALIGN_EPI) { if (wr == 0) PG8_BAR; }
    PG8_BAR;
    if constexpr (Epi::AFTER_DRAIN) { E.fused(acc, cur, wr, wc, fr, fq, lds, wid, lane); S.done(cur); }
#undef PG8_SA
#undef PG8_SB
#undef PG8_STAGE
#undef PG8_LDA
#undef PG8_LDB
#undef PG8_MMA
#undef PG8_WAIT_V
#undef PG8_WAIT_L
#undef PG8_BAR
#undef PG8_SCHED
}
}

struct EpiInProj {
  static constexpr bool PERM = false, AFTER_DRAIN = false;
  char* ws; const float* gq; const float* gk; const float* swl;
  __device__ __forceinline__ float row_rstd(int t) const {
    const f32x4* q = (const f32x4*)(ws + OFF_SSQX) + (size_t)t * 4; const f32x4 a = q[0], b = q[1], c = q[2], d = q[3];
    const float s = ((a[0] + a[1]) + (a[2] + a[3])) + ((b[0] + b[1]) + (b[2] + b[3])) + ((c[0] + c[1]) + (c[2] + c[3])) + ((d[0] + d[1]) + (d[2] + d[3]));
    return rsqrtf(s * (1.f / 1024.f) + EPS); }
  __device__ __forceinline__ void operator()(const f32x4 (&acc0)[2][2][4][2], const pg8::Unit& u, int wr, int wc, int fr, int fq) const {
    const int pn = u.pn, rb = u.pm * 256 + wr * 64 + fr;
    const float2* ROPE = (const float2*)(ws + OFF_ROPE);
    int bb0, s00; tok_info(u.pm * 256, bb0, s00);
    const float* sw = swl + (size_t)bb0 * NPAD + pn * 256 + wc * 32 + fq * 4;
    f32x4 swv[2][2];
#pragma unroll
    for (int bj = 0; bj < 2; ++bj)
#pragma unroll
      for (int n = 0; n < 2; ++n) swv[bj][n] = *(const f32x4*)(sw + bj * 128 + n * 16);
#define AV(bj, n) (acc0[ai][bj][m][n] * rs + swv[bj][n])
    if (pn == 0) {
      bf16_t* Q = (bf16_t*)(ws + OFF_QLAT); float* ssq = (float*)(ws + OFF_SSQQ);
#pragma unroll
      for (int ai = 0; ai < 2; ++ai)
#pragma unroll
        for (int m = 0; m < 4; ++m) { const int t = rb + ai * 128 + m * 16; const float rs = row_rstd(t); float ss = 0.f;
#pragma unroll
          for (int bj = 0; bj < 2; ++bj)
#pragma unroll
            for (int n = 0; n < 2; ++n) { const f32x4 v = AV(bj, n); ss += v[0] * v[0] + v[1] * v[1] + v[2] * v[2] + v[3] * v[3];
              st_bf4(Q + (size_t)t * 256 + bj * 128 + wc * 32 + n * 16 + fq * 4, v); }
          ss += __shfl_xor(ss, 16); ss += __shfl_xor(ss, 32);
          if (fq == 0) ssq[t * 4 + wc] = ss; }
    } else if (pn == 1) {
      bf16_t* KV = (bf16_t*)(ws + OFF_KVLAT); float* ssq = (float*)(ws + OFF_SSQKV); bf16_t* KR = (bf16_t*)(ws + OFF_KROPE);
#pragma unroll
      for (int ai = 0; ai < 2; ++ai)
#pragma unroll
        for (int m = 0; m < 4; ++m) { const int t = rb + ai * 128 + m * 16; const float rs = row_rstd(t); float ss = 0.f;
#pragma unroll
          for (int n = 0; n < 2; ++n) { const f32x4 v = AV(0, n); ss += v[0] * v[0] + v[1] * v[1] + v[2] * v[2] + v[3] * v[3];
            st_bf4(KV + (size_t)t * 128 + wc * 32 + n * 16 + fq * 4, v); }
          ss += __shfl_xor(ss, 16); ss += __shfl_xor(ss, 32);
          if (fq == 0) ssq[t * 4 + wc] = ss;
          if (wc == 0) { int bb, s; tok_info(t, bb, s);
            f32x4 x1 = AV(1, 0), x2 = AV(1, 1);
            float rs = x1[0] * x1[0] + x1[1] * x1[1] + x1[2] * x1[2] + x1[3] * x1[3] + x2[0] * x2[0] + x2[1] * x2[1] + x2[2] * x2[2] + x2[3] * x2[3];
            rs += __shfl_xor(rs, 16); rs += __shfl_xor(rs, 32);
            if (fq == 0) ((float*)(ws + OFF_KRSS))[t] = rs;
            rope4(x1, x2, ROPE + s * 16 + fq * 4);
            st_bf4(KR + (size_t)t * 32 + fq * 4, x1); st_bf4(KR + (size_t)t * 32 + 16 + fq * 4, x2); } }
    } else if (pn <= 4) {
      if (pn == 4 && wc >= 2) {
#pragma unroll
        for (int ai = 0; ai < 2; ++ai)
#pragma unroll
          for (int m = 0; m < 4; ++m) { const int t = rb + ai * 128 + m * 16; const float rs = row_rstd(t);
            bf16_t* dst = (bf16_t*)(ws + OFF_VB) + (size_t)hm_row<2>(t, wc - 2) * 64 + fq * 4;
#pragma unroll
            for (int bj = 0; bj < 2; ++bj)
#pragma unroll
              for (int n = 0; n < 2; ++n) st_bf4(dst + bj * 32 + n * 16, AV(bj, n)); }
      } else {
        const float* gv = pn < 4 ? gq : gk;
        f32x4 g[2][2];
#pragma unroll
        for (int bj = 0; bj < 2; ++bj)
#pragma unroll
          for (int n = 0; n < 2; ++n) g[bj][n] = *(const f32x4*)(gv + bj * 32 + n * 16 + fq * 4);
#pragma unroll
        for (int ai = 0; ai < 2; ++ai)
#pragma unroll
          for (int m = 0; m < 4; ++m) { const int t = rb + ai * 128 + m * 16; const float rs = row_rstd(t); int bb, s; tok_info(t, bb, s); float ss = 0.f;
#pragma unroll
            for (int bj = 0; bj < 2; ++bj)
#pragma unroll
              for (int n = 0; n < 2; ++n) { const f32x4 v = AV(bj, n); ss += v[0] * v[0] + v[1] * v[1] + v[2] * v[2] + v[3] * v[3]; }
            ss += __shfl_xor(ss, 16); ss += __shfl_xor(ss, 32);
            const float rstd = rsqrtf(ss * (1.f / 64.f) + EPS) * (pn < 4 ? C_GQA : 1.f);
            f32x4 y[2][2];
#pragma unroll
            for (int bj = 0; bj < 2; ++bj)
#pragma unroll
              for (int n = 0; n < 2; ++n) { const f32x4 v = AV(bj, n), gg = g[bj][n];
                y[bj][n][0] = v[0] * rstd * gg[0]; y[bj][n][1] = v[1] * rstd * gg[1]; y[bj][n][2] = v[2] * rstd * gg[2]; y[bj][n][3] = v[3] * rstd * gg[3]; }
            rope4(y[0][0], y[0][1], ROPE + (s >> 6) * 16 + fq * 4);
            rope4(y[1][0], y[1][1], ROPE + (s & 63) * 16 + fq * 4);
            bf16_t* dst = pn < 4 ? (bf16_t*)(ws + OFF_QB) + (size_t)t * 512 + ((pn - 2) * 4 + wc) * 64 + fq * 4
                                 : (bf16_t*)(ws + OFF_KB) + (size_t)hm_row<2>(t, wc) * 64 + fq * 4;
#pragma unroll
            for (int bj = 0; bj < 2; ++bj)
#pragma unroll
              for (int n = 0; n < 2; ++n) st_bf4(dst + bj * 32 + n * 16, y[bj][n]); }
      }
    } else {
      bf16_t* G = (bf16_t*)(ws + OFF_G);
#pragma unroll
      for (int ai = 0; ai < 2; ++ai)
#pragma unroll
        for (int m = 0; m < 4; ++m) { const int t = rb + ai * 128 + m * 16; const float rs = row_rstd(t);
#pragma unroll
          for (int bj = 0; bj < 2; ++bj)
#pragma unroll
            for (int n = 0; n < 2; ++n) { const f32x4 a = AV(bj, n); f32x4 v; v[0] = silu_f(a[0]); v[1] = silu_f(a[1]); v[2] = silu_f(a[2]); v[3] = silu_f(a[3]);
              st_bf4(G + (size_t)t * 1024 + (pn - 5) * 256 + bj * 128 + wc * 32 + n * 16 + fq * 4, v); } }
    }
  }
#undef AV
};
struct EpiOutProj {
  static constexpr bool PERM = false, AFTER_DRAIN = false;
  const float* xp; const float* xs; float* out; const float* modl; int first;
  const float* gnext; bf16_t* H; float* ssqx; int has_next;
  __device__ __forceinline__ void operator()(const f32x4 (&acc)[2][2][4][2], const pg8::Unit& u, int wr, int wc, int fr, int fq) const {
    const int rb = u.pm * 256 + wr * 64 + fr, cb = u.pn * 256 + wc * 32 + fq * 4;
    int bb, s0; tok_info(u.pm * 256, bb, s0);
    const float* gate = modl + (size_t)bb * 3072 + 2048;
    const float* scn = modl + (size_t)(6 + bb) * 3072 + 1024;
    f32x4 gv[2][2], gm[2][2];
#pragma unroll
    for (int bj = 0; bj < 2; ++bj)
#pragma unroll
      for (int n = 0; n < 2; ++n) { const int c = cb + bj * 128 + n * 16; gv[bj][n] = *(const f32x4*)(gate + c);
        if (has_next) { const f32x4 g = *(const f32x4*)(gnext + c), s = *(const f32x4*)(scn + c);
          gm[bj][n][0] = g[0] * (1.f + s[0]); gm[bj][n][1] = g[1] * (1.f + s[1]); gm[bj][n][2] = g[2] * (1.f + s[2]); gm[bj][n][3] = g[3] * (1.f + s[3]); } }
#define XPTR(t_) (first ? ((t_) < TOKP ? xp + (size_t)(t_) * DM : xs + (size_t)((t_) - TOKP) * DM) : out + (size_t)(t_) * DM)
    f32x4 xc[2][2], xn[2][2];
    { const float* x0 = XPTR(rb);
#pragma unroll
      for (int bj = 0; bj < 2; ++bj)
#pragma unroll
        for (int n = 0; n < 2; ++n) xc[bj][n] = *(const f32x4*)(x0 + cb + bj * 128 + n * 16); }
#pragma unroll
    for (int ai = 0; ai < 2; ++ai)
#pragma unroll
      for (int m = 0; m < 4; ++m) { const int t = rb + ai * 128 + m * 16; float ss = 0.f;
        if (ai * 4 + m < 7) { const int tn = rb + ((ai * 4 + m + 1) >> 2) * 128 + ((ai * 4 + m + 1) & 3) * 16; const float* x1 = XPTR(tn);
#pragma unroll
          for (int bj = 0; bj < 2; ++bj)
#pragma unroll
            for (int n = 0; n < 2; ++n) xn[bj][n] = *(const f32x4*)(x1 + cb + bj * 128 + n * 16); }
#pragma unroll
        for (int bj = 0; bj < 2; ++bj)
#pragma unroll
          for (int n = 0; n < 2; ++n) { const int c = cb + bj * 128 + n * 16; const f32x4 g = gv[bj][n], x = xc[bj][n], a = acc[ai][bj][m][n];
            f32x4 o; o[0] = x[0] + g[0] * a[0]; o[1] = x[1] + g[1] * a[1]; o[2] = x[2] + g[2] * a[2]; o[3] = x[3] + g[3] * a[3];
            *(f32x4*)(out + (size_t)t * DM + c) = o;
            if (has_next) { ss += o[0] * o[0] + o[1] * o[1] + o[2] * o[2] + o[3] * o[3];
              f32x4 h; h[0] = o[0] * gm[bj][n][0]; h[1] = o[1] * gm[bj][n][1]; h[2] = o[2] * gm[bj][n][2]; h[3] = o[3] * gm[bj][n][3];
              st_bf4(H + (size_t)t * DM + c, h); } }
        if (has_next) { ss += __shfl_xor(ss, 16); ss += __shfl_xor(ss, 32); if (fq == 0) ssqx[t * 16 + u.pn * 4 + wc] = ss; }
#pragma unroll
        for (int bj = 0; bj < 2; ++bj)
#pragma unroll
          for (int n = 0; n < 2; ++n) xc[bj][n] = xn[bj][n]; }
#undef XPTR
  }
};

struct EpiKvUp {
  static constexpr bool PERM = false, AFTER_DRAIN = false;
  char* ws; int l;
  __device__ __forceinline__ void operator()(const f32x4 (&acc)[2][2][4][2], const pg8::Unit& u, int wr, int wc, int fr, int fq) const {
    const int rb = u.pm * 256 + wr * 64 + fr;
    const float* SSQKV = (const float*)(ws + OFF_SSQKV); const float* KRSS = (const float*)(ws + OFF_KRSS);
    bf16_t* KVA = (bf16_t*)(ws + OFF_H);
    float kmx[2] = {0.f, 0.f};
#pragma unroll
    for (int ai = 0; ai < 2; ++ai)
#pragma unroll
      for (int m = 0; m < 4; ++m) { const int t = rb + ai * 128 + m * 16;
        const f32x4 sq = *(const f32x4*)(SSQKV + (size_t)t * 4);
        const float rstd = rsqrtf((sq[0] + sq[1] + sq[2] + sq[3]) * (1.f / 128.f) + EPS);
        const float kr = wc == 0 ? KRSS[t] : 0.f;
#pragma unroll
        for (int bj = 0; bj < 2; ++bj) { bf16_t* dst = KVA + (size_t)hm_row<8>(t, u.pn * 2 + bj) * 128 + wc * 32 + fq * 4; float ss = 0.f;
#pragma unroll
          for (int n = 0; n < 2; ++n) { const f32x4 v = acc[ai][bj][m][n] * rstd; ss += v[0] * v[0] + v[1] * v[1] + v[2] * v[2] + v[3] * v[3]; st_bf4(dst + n * 16, v); }
          ss += __shfl_xor(ss, 16); ss += __shfl_xor(ss, 32);
          kmx[bj] = fmaxf(kmx[bj], ss + kr); } }
    if (wc < 2) {
      int bb, s0; tok_info(u.pm * 256, bb, s0);
      unsigned* KM = wc == 0 ? (unsigned*)(ws + OFF_KMAX) : (unsigned*)(ws + OFF_BAR) + 3584;
#pragma unroll
      for (int bj = 0; bj < 2; ++bj) { float v = kmx[bj];
#pragma unroll
        for (int off = 1; off < 16; off <<= 1) v = fmaxf(v, __shfl_xor(v, off));
        if (fr == 0 && fq == 0) atomicMax(KM + (l * 6 + bb) * 8 + u.pn * 2 + bj, __float_as_uint(v)); }
    }
  }
};

#define KOFF(row, chunk) ((row) * 256 + ((((chunk)) ^ ((row) & 15)) << 4))
constexpr int A_SHM_V = 8192, A_SHM_K = 16384;
__device__ __forceinline__ int v_st(int k, int c) { const int kk = (k & ~0xC) | ((k & 4) << 1) | ((k & 8) >> 1); return ((kk >> 3) * 2 + (c >> 5)) * 512 + ((kk & 7) * 32 + (c & 31)) * 2; }
__device__ __forceinline__ int v_rd_base(int lane) { return ((lane & 3) << 3) | (((lane >> 2) & 3) << 6) | (((lane >> 4) & 1) << 5) | (((lane >> 5) & 1) << 8); }
constexpr int v_rd_off(int d0, int ks, int half) { return d0 * 512 + ks * 2048 + half * 1024; }
template <int OFF> __device__ __forceinline__ s16x4 tr_read(int vb) {
  s16x4 r; asm volatile("ds_read_b64_tr_b16 %0, %1 offset:%2" : "=&v"(r) : "v"(vb), "i"(OFF) : "memory"); return r;
}
template <int D0> __device__ __forceinline__ void pv_one(f32x16& od, int vb, bf16x8 pa0, bf16x8 pa1, bf16x8 pa2, bf16x8 pa3) {
  const s16x4 l0 = tr_read<v_rd_off(D0, 0, 0)>(vb), h0 = tr_read<v_rd_off(D0, 0, 1)>(vb), l1 = tr_read<v_rd_off(D0, 1, 0)>(vb), h1 = tr_read<v_rd_off(D0, 1, 1)>(vb);
  const s16x4 l2 = tr_read<v_rd_off(D0, 2, 0)>(vb), h2 = tr_read<v_rd_off(D0, 2, 1)>(vb), l3 = tr_read<v_rd_off(D0, 3, 0)>(vb), h3 = tr_read<v_rd_off(D0, 3, 1)>(vb);
  asm volatile("s_waitcnt lgkmcnt(0)" ::: "memory"); SBAR();
#define PK(L, H) (bf16x8){L[0], L[1], L[2], L[3], H[0], H[1], H[2], H[3]}
  od = __builtin_amdgcn_mfma_f32_32x32x16_bf16(pa0, PK(l0, h0), od, 0, 0, 0);
  od = __builtin_amdgcn_mfma_f32_32x32x16_bf16(pa1, PK(l1, h1), od, 0, 0, 0);
  od = __builtin_amdgcn_mfma_f32_32x32x16_bf16(pa2, PK(l2, h2), od, 0, 0, 0);
  od = __builtin_amdgcn_mfma_f32_32x32x16_bf16(pa3, PK(l3, h3), od, 0, 0, 0);
#undef PK
}
#define PK4(P, BASE, OUT) do { unsigned a0_ = cvtpk(P[BASE + 0], P[BASE + 1]), a1_ = cvtpk(P[BASE + 2], P[BASE + 3]);   \
    unsigned b0_ = cvtpk(P[BASE + 4], P[BASE + 5]), b1_ = cvtpk(P[BASE + 6], P[BASE + 7]);                              \
    auto r0_ = __builtin_amdgcn_permlane32_swap(a0_, b0_, false, false); auto r1_ = __builtin_amdgcn_permlane32_swap(a1_, b1_, false, false); \
    u32x4 w_ = {r0_[0], r1_[0], r0_[1], r1_[1]}; OUT = *reinterpret_cast<bf16x8*>(&w_); } while (0)

constexpr float ATT_THRL = 11.5f;
template <int DQK>
__device__ __forceinline__ void partialSM(f32x16& p0, f32x16& p1, float& m_reg, float& mn, float& alpha) {
  float pmax = p0[0];
#pragma unroll
  for (int r = 1; r < 16; ++r) pmax = fmaxf(pmax, p0[r]);
#pragma unroll
  for (int r = 0; r < 16; ++r) pmax = fmaxf(pmax, p1[r]);
  { auto rr = __builtin_amdgcn_permlane32_swap(__float_as_uint(pmax), __float_as_uint(pmax), false, false);
    pmax = fmaxf(__uint_as_float(rr[0]), __uint_as_float(rr[1])); }
  if (__builtin_expect(__all(pmax - m_reg <= ATT_THRL), 1)) { mn = m_reg; alpha = 1.f; }
  else { mn = fmaxf(m_reg, pmax); alpha = __builtin_amdgcn_exp2f(m_reg - mn); m_reg = mn; }
#pragma unroll
  for (int r = 0; r < 16; ++r) p0[r] = p0[r] - mn;
#pragma unroll
  for (int r = 0; r < 16; ++r) p1[r] = p1[r] - mn;
#pragma unroll
  for (int r = 0; r < 16; ++r) p0[r] = __builtin_amdgcn_exp2f(p0[r]);
}
__device__ __forceinline__ void finishSM(f32x16& p0, f32x16& p1, float alpha, float& l_reg, bf16x8& pa0, bf16x8& pa1, bf16x8& pa2, bf16x8& pa3) {
#pragma unroll
  for (int r = 0; r < 16; ++r) p1[r] = __builtin_amdgcn_exp2f(p1[r]);
  float ps = 0;
#pragma unroll
  for (int r = 0; r < 16; ++r) ps += p0[r];
#pragma unroll
  for (int r = 0; r < 16; ++r) ps += p1[r];
  { auto rr = __builtin_amdgcn_permlane32_swap(__float_as_uint(ps), __float_as_uint(ps), false, false);
    ps = __uint_as_float(rr[0]) + __uint_as_float(rr[1]); }
  l_reg = l_reg * alpha + ps;
  PK4(p0, 0, pa0); PK4(p0, 8, pa1); PK4(p1, 0, pa2); PK4(p1, 8, pa3);
}
template <int DQK>
__device__ __forceinline__ void qkt(f32x16& p0, f32x16& p1, const char* Ks, const bf16x8 (&qr)[DQK / 16], int r32, int hi) {
  p0 = f32x16{}; p1 = f32x16{};
#pragma unroll
  for (int d0 = 0; d0 < DQK / 16; ++d0) { const int ch = d0 * 2 + hi;
    const bf16x8 b0 = *reinterpret_cast<const bf16x8*>(Ks + KOFF(r32, ch));
    const bf16x8 b1 = *reinterpret_cast<const bf16x8*>(Ks + KOFF(32 + r32, ch));
    p0 = __builtin_amdgcn_mfma_f32_32x32x16_bf16(b0, qr[d0], p0, 0, 0, 0);
    p1 = __builtin_amdgcn_mfma_f32_32x32x16_bf16(b1, qr[d0], p1, 0, 0, 0); }
}

template <int DQK>
__device__ __forceinline__ void attn_body(const bf16x8 (&qr)[DQK / 16], const bf16_t* __restrict__ Kg, int kld, const bf16_t* __restrict__ Krg,
                                          const bf16_t* __restrict__ Vg, int vld, int seq, bf16_t* __restrict__ Gout, char* lds, bool live) {
  const int tid = opaque_tid(), wid = uni(tid >> 6), lane = tid & 63, r32 = lane & 31, hi = lane >> 5;
  char* V_lds = lds; char* K_lds = lds + 2 * A_SHM_V;
  float* ws = (float*)(lds + 2 * A_SHM_V + 2 * A_SHM_K) + wid * 64; float* li_l = ws; float* al_l = ws + 32;
  float m_reg = -1e30f, l_reg = 0; f32x16 o[2] = {};
  const int srow = tid >> 3, sch = tid & 7, rrow = (tid & 255) >> 2, rch = tid & 3;
  const int vst = v_st(srow, sch * 8), kst = KOFF(srow, sch), rst = KOFF(rrow, 8 + rch);
  const int vb0 = (int)(uintptr_t)V_lds + v_rd_base(lane);
  const bf16_t* Kp = Kg + (size_t)srow * kld + sch * 8;
  const bf16_t* Vp = Vg + (size_t)srow * vld + sch * 8;
  const bf16_t* Rp = (DQK == 96) ? Krg + (size_t)rrow * 32 + rch * 8 : nullptr;
  u32x4 k_s0, v_s0, r_s0;
#define SLOAD0(k0) do { k_s0 = *(const u32x4*)(Kp + (size_t)(k0) * kld); v_s0 = *(const u32x4*)(Vp + (size_t)(k0) * vld); if (DQK == 96) r_s0 = *(const u32x4*)(Rp + (size_t)(k0) * 32); } while (0)
#define SWRITE0(b) do { *(u32x4*)(V_lds + (b) * A_SHM_V + vst) = v_s0; *(u32x4*)(K_lds + (b) * A_SHM_K + kst) = k_s0; if (DQK == 96) *(u32x4*)(K_lds + (b) * A_SHM_K + rst) = r_s0; } while (0)
#define RESC(a) do { if (__any((a) < 1.f)) { if (hi == 0) al_l[r32] = (a); asm volatile("s_waitcnt lgkmcnt(0)" ::: "memory"); \
    _Pragma("unroll") for (int d = 0; d < 2; ++d) _Pragma("unroll") for (int r = 0; r < 16; ++r) o[d][r] *= al_l[crow(r, hi)]; } } while (0)
#define PVALL(vb) do { pv_one<0>(o[0], (vb), pa0, pa1, pa2, pa3); pv_one<1>(o[1], (vb), pa0, pa1, pa2, pa3); } while (0)
  f32x16 pA0, pA1, pB0, pB1; float mnA, mnB, alA, alB; bf16x8 pa0, pa1, pa2, pa3; const int NT = seq / 64;
  SLOAD0(0); SWRITE0(0); __syncthreads();
  qkt<DQK>(pA0, pA1, K_lds, qr, r32, hi); partialSM<DQK>(pA0, pA1, m_reg, mnA, alA);
  SLOAD0(64); SWRITE0(1); __syncthreads();
  for (int j = 1; j + 1 < NT; j += 2) {
    SBAR(); qkt<DQK>(pB0, pB1, K_lds + A_SHM_K, qr, r32, hi);
    finishSM(pA0, pA1, alA, l_reg, pa0, pa1, pa2, pa3); SBAR();
    SLOAD0((j + 1) * 64); SBAR();
    PVALL(vb0); partialSM<DQK>(pB0, pB1, m_reg, mnB, alB);
    __syncthreads(); SWRITE0(0);
    RESC(alB); __syncthreads();
    SBAR(); qkt<DQK>(pA0, pA1, K_lds, qr, r32, hi);
    finishSM(pB0, pB1, alB, l_reg, pa0, pa1, pa2, pa3); SBAR();
    SLOAD0((j + 2) * 64); SBAR();
    PVALL(vb0 + A_SHM_V); partialSM<DQK>(pA0, pA1, m_reg, mnA, alA);
    __syncthreads(); SWRITE0(1);
    RESC(alA); __syncthreads();
  }
  SBAR(); qkt<DQK>(pB0, pB1, K_lds + A_SHM_K, qr, r32, hi);
  finishSM(pA0, pA1, alA, l_reg, pa0, pa1, pa2, pa3); SBAR();
  PVALL(vb0); partialSM<DQK>(pB0, pB1, m_reg, mnB, alB);
  __syncthreads(); RESC(alB);
  finishSM(pB0, pB1, alB, l_reg, pa0, pa1, pa2, pa3); SBAR();
  PVALL(vb0 + A_SHM_V);
  if (hi == 0) li_l[r32] = l_reg; asm volatile("s_waitcnt lgkmcnt(0)" ::: "memory");
  float rli[16];
#pragma unroll
  for (int r = 0; r < 16; ++r) rli[r] = __builtin_amdgcn_rcpf(li_l[crow(r, hi)]);
  bf16_t* Gw = Gout + (size_t)(wid * 32) * 1024 + r32;
  if (live) {
#pragma unroll
  for (int r = 0; r < 16; ++r) { const int orow = crow(r, hi);
#pragma unroll
    for (int d0 = 0; d0 < 2; ++d0) { bf16_t* gp = Gw + (size_t)orow * 1024 + d0 * 32; const float g = bf2f(*gp); *gp = f2bf(o[d0][r] * rli[r] * g); } }
  }
  __syncthreads();
#undef SLOAD0
#undef SWRITE0
#undef RESC
#undef PVALL
}


#define PK4S(P, BASE, OUT) do { unsigned a0_ = cvtpk_s(P[BASE + 0], P[BASE + 1]), a1_ = cvtpk_s(P[BASE + 2], P[BASE + 3]);   \
    unsigned b0_ = cvtpk_s(P[BASE + 4], P[BASE + 5]), b1_ = cvtpk_s(P[BASE + 6], P[BASE + 7]);                              \
    auto r0_ = __builtin_amdgcn_permlane32_swap(a0_, b0_, false, false); auto r1_ = __builtin_amdgcn_permlane32_swap(a1_, b1_, false, false); \
    u32x4 w_ = {r0_[0], r1_[0], r0_[1], r1_[1]}; OUT = *reinterpret_cast<bf16x8*>(&w_); } while (0)
constexpr int F_KN0 = 3 * 8192, F_KR0 = F_KN0 + 3 * 8192, F_RED = F_KR0 + 3 * 4096;
template <int DQK, class QF>
__device__ __forceinline__ bool attn_body_fast(QF qf, const bf16_t* __restrict__ Kg, int kld, const bf16_t* __restrict__ Krg,
                                               const bf16_t* __restrict__ Vg, int vld, int seq, bf16_t* __restrict__ Gout, char* lds, bool pre, bool pf) {
  constexpr long NDK = DQK == 96 ? 65536L * 128 : 16384L * 64;
  constexpr long NDR = 8192L * 32;
  const int tid = opaque_tid(), wid = uni(tid >> 6), lane = tid & 63, r32 = lane & 31, hi = lane >> 5;
  LAS unsigned char* L = (LAS unsigned char*)lds;
  f32x16 o0 = {}, o1 = {}; float l0 = 0.f, l1 = 0.f;
  const int vb0 = (int)(uintptr_t)lds + v_rd_base(lane);
  int kn_a[4], kr_a[2];
#pragma unroll
  for (int d0 = 0; d0 < 4; ++d0) kn_a[d0] = F_KN0 + r32 * 128 + (((d0 * 2 + hi) ^ ((r32 >> 1) & 7)) << 4);
#pragma unroll
  for (int d0 = 0; d0 < 2; ++d0) kr_a[d0] = F_KR0 + r32 * 64 + (((d0 * 2 + hi) ^ ((r32 >> 2) & 3)) << 4);
  unsigned voffV, voffK, voffR = 0;
  { const int b = wid * 1024 + lane * 16;
    { const int sub = b >> 9, k = (sub >> 1) * 8 + ((b & 511) >> 6), c = (sub & 1) * 32 + ((b & 63) >> 1); voffV = (unsigned)(k * vld + c) * 2u; }
    { const int row = b >> 7, c = ((b & 127) >> 4) ^ ((row >> 1) & 7); voffK = (unsigned)(row * kld + c * 8) * 2u; }
    if (DQK == 96) { const int row = (b & 4095) >> 6, c = ((b & 63) >> 4) ^ ((row >> 2) & 3); voffR = (unsigned)(row * 32 + c * 8) * 2u; } }
  const char* bV = (const char*)Vg; const char* bK = (const char*)Kg; const char* bR = (const char*)Krg;
  const int stV = 64 * vld * 2, stK = 64 * kld * 2;
#define DMA(slot) do { \
    __builtin_amdgcn_global_load_lds((const unsigned*)(bV + voffV), (LAS unsigned*)(L + (slot) * 8192 + wid * 1024), 16, 0, 0); bV += stV; \
    __builtin_amdgcn_global_load_lds((const unsigned*)(bK + voffK), (LAS unsigned*)(L + F_KN0 + (slot) * 8192 + wid * 1024), 16, 0, 0); bK += stK; \
    if (DQK == 96) { if (wid < 4) __builtin_amdgcn_global_load_lds((const unsigned*)(bR + voffR), (LAS unsigned*)(L + F_KR0 + (slot) * 4096 + wid * 1024), 16, 0, 0); bR += 64 * 32 * 2; } } while (0)
#define LANDED() do { asm volatile("s_waitcnt vmcnt(0)" ::: "memory"); __syncthreads(); } while (0)
#define QK(N0, N1, slot) do { N0 = f32x16{}; N1 = f32x16{}; bf16x8 kf0_[DQK / 16], kf1_[DQK / 16]; \
    _Pragma("unroll") for (int d0 = 0; d0 < 4; ++d0) { kf0_[d0] = *(const LAS bf16x8*)(L + kn_a[d0] + (slot) * 8192); kf1_[d0] = *(const LAS bf16x8*)(L + kn_a[d0] + (slot) * 8192 + 4096); } \
    if (DQK == 96) { _Pragma("unroll") for (int d0 = 0; d0 < 2; ++d0) { kf0_[DQK / 16 - 2 + d0] = *(const LAS bf16x8*)(L + kr_a[d0] + (slot) * 4096); kf1_[DQK / 16 - 2 + d0] = *(const LAS bf16x8*)(L + kr_a[d0] + (slot) * 4096 + 2048); } } \
    SBAR();   \
    _Pragma("unroll") for (int d0 = 0; d0 < DQK / 16; ++d0) { \
      N0 = __builtin_amdgcn_mfma_f32_32x32x16_bf16(kf0_[d0], qr[d0], N0, 0, 0, 0); N1 = __builtin_amdgcn_mfma_f32_32x32x16_bf16(kf1_[d0], qr[d0], N1, 0, 0, 0); } } while (0)
#define PKP(P, B) (bf16x8)__builtin_bit_cast(bf16x8, (u32x4){cvtpk_s(P[B + 0], P[B + 1]), cvtpk_s(P[B + 2], P[B + 3]), cvtpk_s(P[B + 4], P[B + 5]), cvtpk_s(P[B + 6], P[B + 7])})
#define FIN(P0, P1) do { _Pragma("unroll") for (int r = 0; r < 16; ++r) { P1[r] = __builtin_amdgcn_exp2f(P1[r]); if (r & 1) l1 += P1[r]; else l0 += P1[r]; } \
    pa0 = PKP(P0, 0); pa1 = PKP(P0, 8); pa2 = PKP(P1, 0); pa3 = PKP(P1, 8); } while (0)
#define PK(L_, H_) (bf16x8){L_[0], L_[1], L_[2], L_[3], H_[0], H_[1], H_[2], H_[3]}
#define PVX(slot, N0, DOEXP) do { const int vb = vb0; \
    s16x4 a0 = tr_read<v_rd_off(0, 0, 0) + (slot) * 8192>(vb), a1 = tr_read<v_rd_off(0, 0, 1) + (slot) * 8192>(vb), a2 = tr_read<v_rd_off(0, 1, 0) + (slot) * 8192>(vb), a3 = tr_read<v_rd_off(0, 1, 1) + (slot) * 8192>(vb); \
    s16x4 a4 = tr_read<v_rd_off(0, 2, 0) + (slot) * 8192>(vb), a5 = tr_read<v_rd_off(0, 2, 1) + (slot) * 8192>(vb), a6 = tr_read<v_rd_off(0, 3, 0) + (slot) * 8192>(vb), a7 = tr_read<v_rd_off(0, 3, 1) + (slot) * 8192>(vb); \
    s16x4 b0 = tr_read<v_rd_off(1, 0, 0) + (slot) * 8192>(vb), b1 = tr_read<v_rd_off(1, 0, 1) + (slot) * 8192>(vb), b2 = tr_read<v_rd_off(1, 1, 0) + (slot) * 8192>(vb), b3 = tr_read<v_rd_off(1, 1, 1) + (slot) * 8192>(vb); \
    s16x4 b4 = tr_read<v_rd_off(1, 2, 0) + (slot) * 8192>(vb), b5 = tr_read<v_rd_off(1, 2, 1) + (slot) * 8192>(vb), b6 = tr_read<v_rd_off(1, 3, 0) + (slot) * 8192>(vb), b7 = tr_read<v_rd_off(1, 3, 1) + (slot) * 8192>(vb); \
    if (DOEXP) { _Pragma("unroll") for (int r = 0; r < 16; ++r) { N0[r] = __builtin_amdgcn_exp2f(N0[r]); if (r & 1) l1 += N0[r]; else l0 += N0[r]; } } \
    asm volatile("s_waitcnt lgkmcnt(0)" : "+v"(a0), "+v"(a1), "+v"(a2), "+v"(a3), "+v"(a4), "+v"(a5), "+v"(a6), "+v"(a7), \
                 "+v"(b0), "+v"(b1), "+v"(b2), "+v"(b3), "+v"(b4), "+v"(b5), "+v"(b6), "+v"(b7) :: "memory");   \
    o0 = __builtin_amdgcn_mfma_f32_32x32x16_bf16(pa0, PK(a0, a1), o0, 0, 0, 0); o1 = __builtin_amdgcn_mfma_f32_32x32x16_bf16(pa0, PK(b0, b1), o1, 0, 0, 0); \
    o0 = __builtin_amdgcn_mfma_f32_32x32x16_bf16(pa1, PK(a2, a3), o0, 0, 0, 0); o1 = __builtin_amdgcn_mfma_f32_32x32x16_bf16(pa1, PK(b2, b3), o1, 0, 0, 0); \
    o0 = __builtin_amdgcn_mfma_f32_32x32x16_bf16(pa2, PK(a4, a5), o0, 0, 0, 0); o1 = __builtin_amdgcn_mfma_f32_32x32x16_bf16(pa2, PK(b4, b5), o1, 0, 0, 0); \
    o0 = __builtin_amdgcn_mfma_f32_32x32x16_bf16(pa3, PK(a6, a7), o0, 0, 0, 0); o1 = __builtin_amdgcn_mfma_f32_32x32x16_bf16(pa3, PK(b6, b7), o1, 0, 0, 0); } while (0)
#define PAIR(SP, SC, SN) do { \
    SBAR(); DMA(SN); SBAR(); QK(sB0, sB1, SC); FIN(sA0, sA1); SBAR(); PVX(SP, sB0, 1); SBAR(); LANDED(); \
    SBAR(); DMA(SP); SBAR(); QK(sA0, sA1, SN); FIN(sB0, sB1); SBAR(); PVX(SC, sA0, 1); SBAR(); LANDED(); } while (0)
  f32x16 sA0, sA1, sB0, sB1; bf16x8 pa0, pa1, pa2, pa3; const int NT = seq / 64;
  if (!pre) { DMA(0); DMA(1); } else { bV += 2 * stV; bK += 2 * stK; bR += 2 * 64 * 32 * 2; }
  bf16x8 qr[DQK / 16];
  const float bound = qf(qr);
  LANDED();
  if (!(bound < 60.f)) {
    attn_body<DQK>(qr, Kg, kld, Krg, Vg, vld, seq, Gout, lds, true);
    return false;
  }
  QK(sA0, sA1, 0);
#pragma unroll
  for (int r = 0; r < 16; ++r) { sA0[r] = __builtin_amdgcn_exp2f(sA0[r]); l0 += sA0[r]; }
  int j = 1, ph = 0;
  for (;;) {
    if (j + 1 >= NT) break;
    PAIR(0, 1, 2); j += 2; ph = 1;
    if (j + 1 >= NT) break;
    PAIR(2, 0, 1); j += 2; ph = 2;
    if (j + 1 >= NT) break;
    PAIR(1, 2, 0); j += 2; ph = 0;
  }
#define TAIL(SP, SC) do { SBAR(); QK(sB0, sB1, SC); FIN(sA0, sA1); SBAR(); PVX(SP, sB0, 1); SBAR(); FIN(sB0, sB1); SBAR(); GLOADS(); SBAR(); PVX(SC, sB0, 0); } while (0)
  bf16_t* Gw = Gout + (size_t)(wid * 32) * 1024 + r32;
  unsigned short gq0[16], gq1[16];
#define GLOADS() do { _Pragma("unroll") for (int r = 0; r < 16; ++r) { const bf16_t* gp_ = Gw + (size_t)crow(r, hi) * 1024; gq0[r] = gp_[0]; gq1[r] = gp_[32]; } } while (0)
  if (ph == 0) TAIL(0, 1); else if (ph == 1) TAIL(2, 0); else TAIL(1, 2);
  if (pf) {
    asm volatile("s_waitcnt lgkmcnt(0)" ::: "memory"); __builtin_amdgcn_s_barrier();
    bV += NDK * 2 - (long)NT * stV; bK += NDK * 2 - (long)NT * stK; if (DQK == 96) bR += NDR * 2 - (long)NT * (64 * 32 * 2);
    DMA(0); DMA(1);
  }
  float l_reg = l0 + l1;
  { auto rr = __builtin_amdgcn_permlane32_swap(__float_as_uint(l_reg), __float_as_uint(l_reg), false, false);
    l_reg = __uint_as_float(rr[0]) + __uint_as_float(rr[1]); }
  float* li_l = (float*)(lds + F_RED + 64) + wid * 32;
  if (hi == 0) li_l[r32] = l_reg; asm volatile("s_waitcnt lgkmcnt(0)" ::: "memory");
#pragma unroll
  for (int r = 0; r < 16; ++r) { const int orow = crow(r, hi); const float rl = __builtin_amdgcn_rcpf(li_l[orow]);
    bf16_t* gp = Gw + (size_t)orow * 1024; const float g0 = bf2f(gq0[r]), g1 = bf2f(gq1[r]);
    gp[0] = f2bf(o0[r] * rl * g0); gp[32] = f2bf(o1[r] * rl * g1); }
  if (pf) { asm volatile("s_waitcnt lgkmcnt(0)" ::: "memory"); __builtin_amdgcn_s_barrier(); }
  else __syncthreads();
  return pf;
#undef DMA
#undef LANDED
#undef QK
#undef PKP
#undef FIN
#undef PK
#undef PVX
#undef PAIR
#undef TAIL
#undef GLOADS
}

__device__ void attn_phase(const Params& p, int l, char* lds, bool live = true) {
  const int tid = opaque_tid(), wid = uni(tid >> 6), lane = tid & 63, r32 = lane & 31, hi = lane >> 5;
  bf16_t* G = (bf16_t*)(p.ws + OFF_G);
  const bf16_t* KVA = (const bf16_t*)(p.ws + OFF_H);
  const bf16_t* KR = (const bf16_t*)(p.ws + OFF_KROPE);
  const bf16_t* QB = (const bf16_t*)(p.ws + OFF_QB);
  const bf16_t* KB = (const bf16_t*)(p.ws + OFF_KB);
  const bf16_t* VB = (const bf16_t*)(p.ws + OFF_VB);
  const bf16_t* QLAT = (const bf16_t*)(p.ws + OFF_QLAT);
  const float* SSQQ = (const float*)(p.ws + OFF_SSQQ);
  const float2* ROPE = (const float2*)(p.ws + OFF_ROPE);
  const bf16_t* WTUQ = (const bf16_t*)(p.ws + OFF_WTUQ) + (size_t)l * 768 * 256;
  int staged_h = -1; bool pre = false;
  for (int it = blockIdx.x; it < 2048; it += gridDim.x) {
    const int step = it >> 8, w = it & 255, cls = step >> 1, sub = step & 1, x = w & 7, j = w >> 3;
    const bool sample = cls < 2, mla = (cls & 1) == 0;
    int bh, qblk;
    if (sample) { bh = sub * 8 + x; qblk = j; } else { bh = (sub * 2 + (j >> 4)) * 8 + x; qblk = j & 15; }
    const int b = bh >> 3, h = bh & 7;
    const int S = sample ? 8192 : 4096;
    const int tseq = sample ? TOKP + b * 8192 : b * 4096;
    const int t0 = tseq + qblk * 256;
    const int trow = t0 + wid * 32 + r32;
    if (mla) {
      const int kmi = (l * 6 + (sample ? 4 + b : b)) * 8 + h;
      const float kmx = __uint_as_float(((const unsigned*)(p.ws + OFF_KMAX))[kmi]) + __uint_as_float(((const unsigned*)(p.ws + OFF_BAR))[3584 + kmi]);
      const int spos = qblk * 256 + wid * 32 + r32;
      const bool need_w = (h != staged_h); staged_h = h;
      auto qf = [=](bf16x8 (&qr)[6]) -> float {
        LAS unsigned char* Lw = (LAS unsigned char*)lds + 65536;
        const f32x4 sq = *(const f32x4*)(SSQQ + (size_t)trow * 4);
        if (need_w) { const char* wbase = (const char*)(WTUQ + (size_t)h * 96 * 256);
          int ln = lane; asm volatile("" : "+v"(ln));
#pragma unroll
          for (int i = 0; i < 6; ++i) { const int pc = wid * 6 + i, row = pc * 2 + (ln >> 5), c = (ln & 31) ^ (row & 31);
            __builtin_amdgcn_global_load_lds((const unsigned*)(wbase + (unsigned)((row * 256 + c * 8) * 2)), (LAS unsigned*)(Lw + pc * 1024), 16, 0, 0); } }
        const bf16_t* qlp = QLAT + (size_t)trow * 256 + hi * 8;
        if (need_w) { asm volatile("s_waitcnt vmcnt(0)" ::: "memory"); __syncthreads(); }
        f32x16 c0 = {}, c1 = {}, c2 = {};
#pragma unroll 8
        for (int ks = 0; ks < 16; ++ks) { const int ao = r32 * 512 + (((ks * 2 + hi) ^ r32) << 4);
          const bf16x8 bk = *(const bf16x8*)(qlp + ks * 16);
          const bf16x8 a0 = *(const LAS bf16x8*)(Lw + ao), a1 = *(const LAS bf16x8*)(Lw + ao + 16384), a2 = *(const LAS bf16x8*)(Lw + ao + 32768);
          c0 = __builtin_amdgcn_mfma_f32_32x32x16_bf16(a0, bk, c0, 0, 0, 0);
          c1 = __builtin_amdgcn_mfma_f32_32x32x16_bf16(a1, bk, c1, 0, 0, 0);
          c2 = __builtin_amdgcn_mfma_f32_32x32x16_bf16(a2, bk, c2, 0, 0, 0);
        }
        const float rstd = rsqrtf((sq[0] + sq[1] + sq[2] + sq[3]) * (1.f / 256.f) + EPS) * C_MLA;
        float qn = 0.f;
#pragma unroll
        for (int r = 0; r < 16; ++r) { c0[r] *= rstd; c1[r] *= rstd; c2[r] *= rstd; qn += c0[r] * c0[r] + c1[r] * c1[r] + c2[r] * c2[r]; }
        const float2* rp = ROPE + (size_t)spos * 16;
#pragma unroll
        for (int r = 0; r < 8; ++r) { const float2 cs = rp[crow(r, hi)]; const float a = c2[r], bq2 = c2[r + 8];
          c2[r] = a * cs.x - bq2 * cs.y; c2[r + 8] = a * cs.y + bq2 * cs.x; }
        PK4(c0, 0, qr[0]); PK4(c0, 8, qr[1]); PK4(c1, 0, qr[2]); PK4(c1, 8, qr[3]); PK4(c2, 0, qr[4]); PK4(c2, 8, qr[5]);
        qn += __shfl_xor(qn, 32);
#pragma unroll
        for (int off = 1; off < 32; off <<= 1) qn = fmaxf(qn, __shfl_xor(qn, off));
        float* red = (float*)(lds + F_RED);
        if (lane == 0) red[wid] = qn;
        __syncthreads();
        float qmx = red[0];
#pragma unroll
        for (int i = 1; i < 8; ++i) qmx = fmaxf(qmx, red[i]);
        return sqrtf(qmx * kmx) * 1.05f;
      };
      const size_t kvrow0 = (size_t)hm_row<8>(tseq, h);
      pre = attn_body_fast<96>(qf, KVA + kvrow0 * 128, 128, KR + (size_t)tseq * 32, KVA + kvrow0 * 128 + 64, 128, S, G + (size_t)t0 * 1024 + h * 64, lds, pre, gridDim.x == 256 && sub == 0);
    } else {
      const size_t kvrow0 = (size_t)hm_row<2>(tseq, h >> 2);
      const float* gqn = p.g_qn + l * 64; const float* gkn = p.g_kn + l * 64;
      auto qf = [=](bf16x8 (&qr)[4]) -> float {
        const bf16_t* qp = QB + (size_t)trow * 512 + h * 64 + hi * 8;
#pragma unroll
        for (int d0 = 0; d0 < 4; ++d0) qr[d0] = *(const bf16x8*)(qp + d0 * 16);
        float gq = fabsf(gqn[lane]), gk = fabsf(gkn[lane]);
#pragma unroll
        for (int off = 1; off < 64; off <<= 1) { gq = fmaxf(gq, __shfl_xor(gq, off)); gk = fmaxf(gk, __shfl_xor(gk, off)); }
        return 64.f * C_GQA * gq * gk * 1.05f;
      };
      pre = attn_body_fast<64>(qf, KB + kvrow0 * 64, 64, nullptr, VB + kvrow0 * 64, 64, S, G + (size_t)t0 * 1024 + 512 + h * 64, lds, pre, gridDim.x == 256 && sub == 0);
    }
  }
}

#define XB_TMO      128
#define XB_XCNT(j)  (256  + 64 * (j))
#define XB_XSUB(j)  (1280 + 64 * (j))
#define XB_XGEN(j)  (2304 + 64 * (j))
#define XB_TOP      3328
#define XB_TOPGEN   3392
#define XCD_BAR_WORDS 3456
#define XB_SPIN_CAP (1u << 18)

__device__ __forceinline__ unsigned xb_ld(unsigned* p)              { return __hip_atomic_load(p, __ATOMIC_RELAXED, __HIP_MEMORY_SCOPE_AGENT); }
__device__ __forceinline__ unsigned xb_add(unsigned* p, unsigned v) { return __hip_atomic_fetch_add(p, v, __ATOMIC_RELAXED, __HIP_MEMORY_SCOPE_AGENT); }
__device__ __forceinline__ unsigned xb_xcc_id() { return (unsigned)__builtin_amdgcn_s_getreg((3 << 11) | 20) & 0xFu; }
#define XB_SPIN(cond, bar) do { unsigned _sp = 0; while (cond) { __builtin_amdgcn_s_sleep(1); \
    if ((++_sp & 255u) == 0u) { if (xb_ld(&(bar)[XB_TMO])) break; if (_sp > XB_SPIN_CAP) { atomicAdd(&(bar)[XB_TMO], 1u); break; } } } } while (0)

struct XcdBarrier {
    unsigned* bar; unsigned x;
    volatile LAS unsigned* st;
};

__device__ __forceinline__ XcdBarrier xcd_barrier_post(unsigned* bar, volatile LAS unsigned* st) {
    XcdBarrier b; b.bar = bar; b.x = xb_xcc_id(); b.st = st;
    if (threadIdx.x == 0) (void)xb_add(&bar[XB_XCNT(b.x)], 1u);
    return b;
}
__device__ __forceinline__ void xcd_barrier_complete(unsigned* bar, unsigned x, unsigned& nloc, unsigned& nx) {
    const unsigned G = gridDim.x * gridDim.y * gridDim.z;
    unsigned sum, cnt, mine, sp = 0u;
    for (;;) {
        sum = 0u; cnt = 0u; mine = 0u;
#pragma unroll
        for (unsigned j = 0; j < 16; ++j) { const unsigned c = xb_ld(&bar[XB_XCNT(j)]); sum += c; cnt += (c > 0u) ? 1u : 0u; mine = (j == x) ? c : mine; }
        if (sum == G) break;
        __builtin_amdgcn_s_sleep(1);
        if ((++sp & 255u) == 0u) { if (xb_ld(&bar[XB_TMO])) break; if (sp > XB_SPIN_CAP) { atomicAdd(&bar[XB_TMO], 1u); break; } }
    }
    nloc = mine > 0u ? mine : 1u; nx = cnt > 0u ? cnt : 1u;
}

__device__ __forceinline__ void xcd_barrier(const XcdBarrier& b) {
    asm volatile("s_waitcnt vmcnt(0)" ::: "memory");
    __syncthreads();
    if (threadIdx.x == 0) {
        unsigned* bar = b.bar; asm volatile("" : "+s"(bar));
        __builtin_amdgcn_s_waitcnt(0);
        unsigned nloc = b.st[0], nx = b.st[1];
        if (nloc == 0u) { xcd_barrier_complete(bar, b.x, nloc, nx); b.st[0] = nloc; b.st[1] = nx; }
        const unsigned old = xb_add(&bar[XB_XSUB(b.x)], 1u);
        const unsigned gen = old / nloc;
        if (old + 1u == (gen + 1u) * nloc) {
            __builtin_amdgcn_fence(__ATOMIC_RELEASE, "agent");
            asm volatile("s_waitcnt vmcnt(0)" ::: "memory");
            const unsigned og = xb_add(&bar[XB_TOP], 1u);
            const unsigned tg = og / nx;
            if (og + 1u == (tg + 1u) * nx) xb_add(&bar[XB_TOPGEN], 1u);
            else XB_SPIN(xb_ld(&bar[XB_TOPGEN]) == tg, bar);
            __builtin_amdgcn_fence(__ATOMIC_ACQUIRE, "agent");
            xb_add(&bar[XB_XGEN(b.x)], 1u);
            asm volatile("s_waitcnt vmcnt(0)" ::: "memory");
        } else {
            XB_SPIN(xb_ld(&bar[XB_XGEN(b.x)]) == gen, bar);
            __builtin_amdgcn_fence(__ATOMIC_ACQUIRE, "agent");
            asm volatile("s_waitcnt vmcnt(0)" ::: "memory");
        }
    }
    __syncthreads();
}


__global__ void __launch_bounds__(NTHR) mk_forward(Params p) {
  extern __shared__ __attribute__((aligned(16))) char smem[];
  cg::grid_group grid = cg::this_grid();
  const bool never = (p.out == nullptr);
  unsigned* bar = (unsigned*)(p.ws + OFF_BAR);
  volatile LAS unsigned* xst = (volatile LAS unsigned*)((LAS unsigned char*)smem + LDS_RING);
  if (threadIdx.x < 4) xst[threadIdx.x] = 0u;
  if (blockIdx.x == 0) for (int i = threadIdx.x; i < 4096; i += NTHR) bar[i] = 0u;
  prologue_phase(p, smem);
  grid.sync();
  (void)xcd_barrier_post(bar, xst);
#define GRID_SYNC() do { XcdBarrier xb_; unsigned* bar_ = (unsigned*)(p.ws + OFF_BAR); asm volatile("" : "+s"(bar_)); unsigned x_ = xb_xcc_id(); asm volatile("" : "+s"(x_)); \
    xb_.bar = bar_; xb_.x = x_; xb_.st = (volatile LAS unsigned*)((LAS unsigned char*)smem + LDS_RING); xcd_barrier(xb_); } while (0)
  norm_phase(p, 0, 0);
  sw_phase(p);
  GRID_SYNC();
  for (int l = 0; l < NLAYER; ++l) {
    { pg8::Gemm g{(const bf16_t*)(p.ws + OFF_H), (const bf16_t*)(p.ws + OFF_WTIN) + (size_t)l * NPAD * 1024, NTOK, NPAD, 1024};
      pg8::StaticOrder S; S.init(NTOK, NPAD, (int)gridDim.x, (int)blockIdx.x);
      EpiInProj E{p.ws, p.g_qn + l * 64, p.g_kn + l * 64, (const float*)(p.ws + OFF_SW) + (size_t)l * 6 * NPAD};
      pg8::gemm_phase<EpiInProj, pg8::StaticOrder, true, true>((PG8_LAS unsigned char*)smem, g, S, E);
#if PROBE_GEMM2
      __syncthreads();
      pg8::gemm_phase<EpiInProj, pg8::StaticOrder, true, true>((PG8_LAS unsigned char*)smem, g, S, E);
#endif
    }
    GRID_SYNC();
    { pg8::Gemm g{(const bf16_t*)(p.ws + OFF_KVLAT), (const bf16_t*)(p.ws + OFF_WTUKV) + (size_t)l * 1024 * 128, NTOK, 1024, 128};
      pg8::StaticOrder S; S.init(NTOK, 1024, (int)gridDim.x, (int)blockIdx.x);
      EpiKvUp E{p.ws, l};
      pg8::gemm_phase<EpiKvUp, pg8::StaticOrder, true, true>((PG8_LAS unsigned char*)smem, g, S, E); }
    GRID_SYNC();
    if (PROBE_ATTN2) attn_phase(p, l, smem, never);
    attn_phase(p, l, smem);
    GRID_SYNC();
    { pg8::Gemm g{(const bf16_t*)(p.ws + OFF_G), (const bf16_t*)(p.ws + OFF_WTOUT) + (size_t)l * 1024 * 1024, NTOK, 1024, 1024};
      pg8::StaticOrder S; S.init(NTOK, 1024, (int)gridDim.x, (int)blockIdx.x);
      EpiOutProj E{p.x_prompt, p.x_sample, p.out, (const float*)(p.ws + OFF_MOD) + (size_t)l * 6 * 3072, l == 0 ? 1 : 0,
                   p.g_norm + (l + 1 < NLAYER ? l + 1 : l) * DM, (bf16_t*)(p.ws + OFF_H), (float*)(p.ws + OFF_SSQX), l + 1 < NLAYER ? 1 : 0};
      pg8::gemm_phase<EpiOutProj, pg8::StaticOrder, true, true>((PG8_LAS unsigned char*)smem, g, S, E); }
    GRID_SYNC();
  }
  norm_phase(p, 0, 1);
}

extern "C" void kernel_launch(void* const* d_in, const int* in_sizes, int n_in, void* d_out, int out_size, void* d_ws, size_t ws_size, hipStream_t stream) {
  static int grid_blocks = 0;
  if (!grid_blocks) {
    if (n_in != 16 || out_size != NTOK * DM || ws_size < WS_END) {
      fprintf(stderr, "kernel_launch: unexpected shapes n_in %d out %d ws %zu (need %zu)\n", n_in, out_size, ws_size, (size_t)WS_END); return; }
    if (hipFuncSetAttribute((const void*)mk_forward, hipFuncAttributeMaxDynamicSharedMemorySize, LDS_BYTES) != hipSuccess) {
      fprintf(stderr, "kernel_launch: hipFuncSetAttribute failed\n"); return; }
    int dev = 0, cus = 0, per_cu = 0;
    hipGetDevice(&dev);
    hipDeviceGetAttribute(&cus, hipDeviceAttributeMultiprocessorCount, dev);
    hipOccupancyMaxActiveBlocksPerMultiprocessor(&per_cu, mk_forward, NTHR, LDS_BYTES);
    if (per_cu < 1) { fprintf(stderr, "kernel_launch: occupancy 0\n"); return; }
    grid_blocks = cus;
  }
  Params p{};
  p.x_prompt = (const float*)d_in[0]; p.x_sample = (const float*)d_in[1]; p.c_prompt = (const float*)d_in[2]; p.c_sample = (const float*)d_in[3];
  p.w_ada = (const float*)d_in[4]; p.b_ada = (const float*)d_in[5]; p.g_norm = (const float*)d_in[6]; p.w_in = (const float*)d_in[7];
  p.g_qa = (const float*)d_in[8]; p.w_uq = (const float*)d_in[9]; p.g_kva = (const float*)d_in[10]; p.w_ukv = (const float*)d_in[11];
  p.g_qn = (const float*)d_in[12]; p.g_kn = (const float*)d_in[13]; p.w_out = (const float*)d_in[14]; p.g_final = (const float*)d_in[15];
  p.out = (float*)d_out; p.ws = (char*)d_ws;
  void* args[] = {&p};
  hipError_t e = hipLaunchCooperativeKernel((const void*)mk_forward, dim3(grid_blocks), dim3(NTHR), args, LDS_BYTES, stream);
  if (e != hipSuccess) fprintf(stderr, "cooperative launch failed: %s (grid %d)\n", hipGetErrorString(e), grid_blocks);
}
```
